# Optimizing an MI355X kernel written in HIP

```python
import math
import jax, jax.numpy as jnp
from jax import lax
import numpy as np

D_MODEL = 1024
BATCH = 8
SEQ = 4096
DEPTH = 1

D_MIX = D_MODEL
MLA_HEADS = 8
MLA_NOPE = 64
MLA_ROPE = 32
MLA_V = 64
MLA_Q_RANK = 256
MLA_KV_RANK = 128
MLA_WIDTH = MLA_HEADS * MLA_V
HG_HEADS = 4
HG_EXPAND = 128
HG_WIDTH = D_MIX - MLA_WIDTH
HG_HEAD_V = HG_WIDTH // HG_HEADS
HG_FDIM = HG_HEADS * HG_EXPAND
HG_CHUNK = 64
Q_BLOCK = 128
ROPE_THETA = 10000.0
EPS = 1e-6
IN_SPLITS = (MLA_Q_RANK, MLA_KV_RANK, MLA_ROPE, MLA_WIDTH,
             HG_FDIM, HG_FDIM, HG_WIDTH, HG_WIDTH)
D_IN = MLA_Q_RANK + MLA_KV_RANK + MLA_ROPE + MLA_WIDTH + 2 * HG_FDIM + 2 * HG_WIDTH

kernel_name = "hybrid_mla_hgrn2_parallel_heads"


def rms_norm(x, g):
    xf = x.astype(jnp.float32)
    y = xf * lax.rsqrt(jnp.mean(xf * xf, axis=-1, keepdims=True) + EPS)
    return (y * g.astype(jnp.float32)).astype(x.dtype)


def rope(x, positions):
    half = x.shape[-1] // 2
    inv = ROPE_THETA ** (-jnp.arange(half, dtype=jnp.float32) / half)
    ang = positions.astype(jnp.float32)[..., None] * inv
    ang = ang.reshape(ang.shape[:2] + (1,) * (x.ndim - 3) + (half,))
    cos, sin = jnp.cos(ang), jnp.sin(ang)
    xf = x.astype(jnp.float32)
    x1, x2 = xf[..., :half], xf[..., half:]
    out = jnp.concatenate([x1 * cos - x2 * sin, x2 * cos + x1 * sin], axis=-1)
    return out.astype(x.dtype)


def mla_group(q_lat, kv_lat, k_rope, positions, q_a_norm_g, w_q_b, kv_a_norm_g, w_kv_b):
    B, S, _ = q_lat.shape
    q = rms_norm(q_lat, q_a_norm_g) @ w_q_b
    q = q.reshape(B, S, MLA_HEADS, MLA_NOPE + MLA_ROPE)
    q_nope, q_pe = q[..., :MLA_NOPE], rope(q[..., MLA_NOPE:], positions)
    kv = (rms_norm(kv_lat, kv_a_norm_g) @ w_kv_b).reshape(B, S, MLA_HEADS, MLA_NOPE + MLA_V)
    k_nope, v = kv[..., :MLA_NOPE], kv[..., MLA_NOPE:]
    k_pe = rope(k_rope, positions)
    scale = 1.0 / math.sqrt(MLA_NOPE + MLA_ROPE)

    nb = S // Q_BLOCK
    qn_b = q_nope.reshape(B, nb, Q_BLOCK, MLA_HEADS, MLA_NOPE).transpose(1, 0, 2, 3, 4)
    qp_b = q_pe.reshape(B, nb, Q_BLOCK, MLA_HEADS, MLA_ROPE).transpose(1, 0, 2, 3, 4)
    kpos = jnp.arange(S)

    def block(args):
        qn, qp, bi = args
        s = (jnp.einsum('bqhd,bkhd->bhqk', qn, k_nope)
             + jnp.einsum('bqhr,bkr->bhqk', qp, k_pe)).astype(jnp.float32) * scale
        qpos = bi * Q_BLOCK + jnp.arange(Q_BLOCK)
        mask = kpos[None, :] <= qpos[:, None]
        s = jnp.where(mask, s, -jnp.inf)
        p = jax.nn.softmax(s, axis=-1).astype(v.dtype)
        return jnp.einsum('bhqk,bkhd->bqhd', p, v)

    out = lax.map(block, (qn_b, qp_b, jnp.arange(nb)))
    return out.transpose(1, 0, 2, 3, 4).reshape(B, S, MLA_WIDTH)


def hgrn2_group(q_in, f_in, i_in, lb, norm_g):
    B, S, _ = q_in.shape
    nc = S // HG_CHUNK
    lbf = lb.astype(jnp.float32)
    f = lbf + (1.0 - lbf) * jax.nn.sigmoid(f_in.astype(jnp.float32))
    log_f = jnp.log(f)
    k = 1.0 - f
    q = jax.nn.silu(q_in.astype(jnp.float32))
    v = i_in.astype(jnp.float32)

    def chunks(t, d):
        return t.reshape(B, nc, HG_CHUNK, HG_HEADS, d).transpose(1, 0, 3, 2, 4)

    qc, kc, gc = chunks(q, HG_EXPAND), chunks(k, HG_EXPAND), chunks(log_f, HG_EXPAND)
    vc = chunks(v, HG_HEAD_V)
    causal = jnp.tril(jnp.ones((HG_CHUNK, HG_CHUNK), dtype=bool))

    def step(state, inp):
        qb, kb, vb, gb = inp
        G = jnp.cumsum(gb, axis=-2)
        diff = G[..., :, None, :] - G[..., None, :, :]
        decay = jnp.exp(jnp.where(causal[:, :, None], diff, -jnp.inf))
        A = jnp.einsum('bhtk,bhtsk,bhsk->bhts', qb, decay, kb)
        o = (jnp.einsum('bhts,bhsv->bhtv', A, vb)
             + jnp.einsum('bhtk,bhkv->bhtv', qb * jnp.exp(G), state))
        G_end = G[..., -1:, :]
        new_state = (state * jnp.exp(G_end)[..., 0, :, None]
                     + jnp.einsum('bhsk,bhsv->bhkv', kb * jnp.exp(G_end - G), vb))
        return new_state, o

    s0 = jnp.zeros((B, HG_HEADS, HG_EXPAND, HG_HEAD_V), jnp.float32)
    _, o = lax.scan(step, s0, (qc, kc, vc, gc))
    o = o.transpose(1, 0, 3, 2, 4).reshape(B, S, HG_HEADS, HG_HEAD_V)
    o = o * lax.rsqrt(jnp.mean(o * o, axis=-1, keepdims=True) + EPS)
    o = o * norm_g.astype(jnp.float32).reshape(HG_HEADS, HG_HEAD_V)
    return o.reshape(B, S, HG_WIDTH).astype(q_in.dtype)


def setup_inputs(seed: int = 0) -> dict:
    key = jax.random.key(seed)
    ks = jax.random.split(key, 12)
    nrm = jax.random.normal
    x = nrm(ks[0], (BATCH, SEQ, D_MODEL), jnp.float32)
    start = jax.random.randint(ks[1], (BATCH, 1), 0, 1024, dtype=jnp.int32)
    positions = (start + jnp.arange(SEQ, dtype=jnp.int32)[None, :]).astype(jnp.int32)
    ln_g = 1.0 + 0.02 * nrm(ks[2], (DEPTH, D_MODEL), jnp.float32)
    w_in = nrm(ks[3], (DEPTH, D_MODEL, D_IN), jnp.float32) * D_MODEL ** -0.5
    q_a_norm_g = 1.0 + 0.02 * nrm(ks[4], (DEPTH, MLA_Q_RANK), jnp.float32)
    w_q_b = nrm(ks[5], (DEPTH, MLA_Q_RANK, MLA_HEADS * (MLA_NOPE + MLA_ROPE)), jnp.float32) * MLA_Q_RANK ** -0.5
    kv_a_norm_g = 1.0 + 0.02 * nrm(ks[6], (DEPTH, MLA_KV_RANK), jnp.float32)
    w_kv_b = nrm(ks[7], (DEPTH, MLA_KV_RANK, MLA_HEADS * (MLA_NOPE + MLA_V)), jnp.float32) * MLA_KV_RANK ** -0.5
    hg_lower_bounds = nrm(ks[8], (DEPTH + 1, HG_FDIM), jnp.float32)
    hg_norm_g = 1.0 + 0.02 * nrm(ks[9], (DEPTH, HG_WIDTH), jnp.float32)
    w_out = nrm(ks[10], (DEPTH, D_MIX, D_MODEL), jnp.float32) * D_MIX ** -0.5
    final_norm_g = 1.0 + 0.02 * nrm(ks[11], (D_MODEL,), jnp.float32)
    return {"x": x, "positions": positions, "ln_g": ln_g, "w_in": w_in,
            "q_a_norm_g": q_a_norm_g, "w_q_b": w_q_b, "kv_a_norm_g": kv_a_norm_g,
            "w_kv_b": w_kv_b, "hg_lower_bounds": hg_lower_bounds, "hg_norm_g": hg_norm_g,
            "w_out": w_out, "final_norm_g": final_norm_g}


def reference(x, positions, ln_g, w_in, q_a_norm_g, w_q_b, kv_a_norm_g, w_kv_b,
              hg_lower_bounds, hg_norm_g, w_out, final_norm_g):
    lb_all = jnp.cumsum(jax.nn.softmax(hg_lower_bounds.astype(jnp.float32), axis=0), axis=0)
    split_pts = [int(p) for p in np.cumsum(IN_SPLITS)[:-1]]
    for l in range(DEPTH):
        h = rms_norm(x, ln_g[l])
        proj = h @ w_in[l]
        q_lat, kv_lat, k_rope, g_mla, hq, hf, hi, g_hg = jnp.split(proj, split_pts, axis=-1)
        y_mla = mla_group(q_lat, kv_lat, k_rope, positions,
                          q_a_norm_g[l], w_q_b[l], kv_a_norm_g[l], w_kv_b[l]) * jax.nn.silu(g_mla)
        y_hg = hgrn2_group(hq, hf, hi, lb_all[l], hg_norm_g[l]) * jax.nn.silu(g_hg)
        y = jnp.concatenate([y_mla, y_hg], axis=-1) @ w_out[l]
        x = x + y.astype(x.dtype)
    return rms_norm(x, final_norm_g)
```

```cpp
#include <hip/hip_runtime.h>
#include <hip/hip_bf16.h>
#include <cstdio>
#include <cstdint>

constexpr int BATCH = 8, SEQ = 4096, DMODEL = 1024, MTOK = BATCH * SEQ;
constexpr int D_IN = 2976, N1 = 3072;
constexpr int NHEAD = 8, NOPE = 64, ROPE = 32, VDIM = 64, QRANK = 256, KVRANK = 128, QHD = NOPE + ROPE;
constexpr int NQ = NHEAD * QHD  , NKV = NHEAD * (NOPE + VDIM)  , MLAW = NHEAD * VDIM  ;
constexpr int HGH = 4, HGD = 128, HGW = 512, CHUNK = 64, NCHUNK = SEQ / CHUNK;
constexpr float EPS = 1e-6f;
constexpr float QSCALE = 0.1472444460259031f;
constexpr int C_QLAT = 0, C_KVLAT = 256, C_KROPE = 384, C_GMLA = 416, C_HQ = 928, C_HF = 1440, C_HI = 1952, C_GHG = 2464;

constexpr size_t MiB = 1u << 20;
constexpr size_t WS_CTL = 0, CTL_ZERO_BYTES = 64 * 1024;
constexpr size_t WS_W1T = 2 * MiB;
constexpr size_t WS_WQT = 8 * MiB;
constexpr size_t WS_WKVT = 8 * MiB + 512 * 1024;
constexpr size_t WS_WOT = 9 * MiB;
constexpr size_t WS_CS = 11 * MiB;
constexpr size_t WS_LB = 15 * MiB;
constexpr size_t WS_SSQQ = 16 * MiB, WS_SSQKV = 16 * MiB + 512 * 1024;
constexpr size_t WS_SSQO = 17 * MiB;
constexpr size_t WS_ER = 19 * MiB, WS_EER = 20 * MiB;
constexpr size_t WS_XN = 32 * MiB;
constexpr size_t WS_Y = 32 * MiB;
constexpr size_t WS_QLAT = 96 * MiB, WS_KVLAT = 112 * MiB, WS_KPE = 120 * MiB;
constexpr size_t WS_GMLA = 128 * MiB, WS_QG = 160 * MiB, WS_KG = 192 * MiB, WS_HV = 224 * MiB, WS_GHG = 256 * MiB;
constexpr size_t WS_Q = 288 * MiB;
constexpr size_t WS_KN = 336 * MiB, WS_V = 368 * MiB;
constexpr size_t WS_OS = 400 * MiB;
constexpr size_t WS_END = 464 * MiB;
constexpr int CW_BAR = 1024;
constexpr int CW_QUEUE = 8192;
static_assert((CW_BAR + 3456) * 4 <= (int)CTL_ZERO_BYTES && (CW_QUEUE + 64 * 16) * 4 <= (int)CTL_ZERO_BYTES, "CTL words inside the memset region");

namespace pg8 {
#define PG8_LAS __attribute__((address_space(3)))
typedef unsigned short bf16_t;
typedef short bf16x8 __attribute__((ext_vector_type(8)));
typedef float f32x4 __attribute__((ext_vector_type(4)));
typedef unsigned u32x4 __attribute__((ext_vector_type(4)));
constexpr int BM = 256, BK = 64, HALF = 128, HTB = HALF * BK * 2  , STAGE_BYTES = 8 * HTB, NXCD = 8, WGM = 8;

__host__ __device__ __forceinline__ int lds_byte(int r, int c) { const int st = (r >> 4) * 2 + (c >> 5), rr = r & 15, cc = c & 31, ob = rr * 64 + cc * 2; return st * 1024 + (ob ^ (((ob >> 9) & 1) << 5)); }
__host__ __device__ __forceinline__ void stage_rc(int b, int& R, int& C) { const int st = b / 1024, sb = b % 1024, swz = sb ^ (((sb >> 9) & 1) << 5); R = (st >> 1) * 16 + swz / 64; C = (st & 1) * 32 + (swz % 64) / 2; }
__host__ __device__ __forceinline__ int perm32(int rho) { const int n = rho >> 4, i = rho & 15; return 8 * (i >> 2) + 4 * n + (i & 3); }

struct Unit { int pm, pn; };
struct Gemm { const bf16_t* A; const bf16_t* Bt; int M, N, K; };

struct StaticOrder {
    int nM, nN, nwg, G, c;
    __host__ __device__ void init(int M, int N, int G_, int c_) { nM = M / BM; nN = N / BM; nwg = nM * nN; G = G_; c = c_; }
    __host__ __device__ bool next(int i, Unit& u) const {
        const long L = (long)i * G + c; if (L >= nwg) return false;
        int wgid = (int)L; { const int q = nwg / NXCD, r = nwg % NXCD, xcd = wgid % NXCD, off = wgid / NXCD; wgid = (xcd < r ? xcd * (q + 1) : r * (q + 1) + (xcd - r) * q) + off; }
        const int nig = WGM * nN, gid = wgid / nig, fm = gid * WGM, gsz = (nM - fm) < WGM ? (nM - fm) : WGM;
        u.pm = fm + ((wgid % nig) % gsz); u.pn = (wgid % nig) / gsz; return true;
    }
    __device__ __forceinline__ void a_ready(const Unit&) const {}
    __device__ __forceinline__ void done(const Unit&) const {}
};

__device__ __forceinline__ unsigned cvt_pk_bf16(float lo, float hi) { unsigned r; asm volatile("v_cvt_pk_bf16_f32 %0, %1, %2" : "=v"(r) : "v"(lo), "v"(hi)); return r; }
typedef float f32x2e __attribute__((ext_vector_type(2)));
__device__ __forceinline__ void st8(bf16_t* p, const f32x4& a, const f32x4& b) {
    u32x4 w; w.x = cvt_pk_bf16(a[0], a[1]); w.y = cvt_pk_bf16(a[2], a[3]); w.z = cvt_pk_bf16(b[0], b[1]); w.w = cvt_pk_bf16(b[2], b[3]);
    *(u32x4*)p = w;
}
__device__ __forceinline__ float sigm(float x) { return __builtin_amdgcn_rcpf(1.0f + __expf(-x)); }
__device__ __forceinline__ float silu_f(float x) { return x * sigm(x); }
__device__ __forceinline__ f32x4 silu4(const f32x4& v) { f32x4 o; o[0] = silu_f(v[0]); o[1] = silu_f(v[1]); o[2] = silu_f(v[2]); o[3] = silu_f(v[3]); return o; }
__device__ __forceinline__ float sq4(const f32x4& v) { return (v[0] * v[0] + v[1] * v[1]) + (v[2] * v[2] + v[3] * v[3]); }
template <int SH> __device__ __forceinline__ float dpp_shr(float v) {
    return __builtin_bit_cast(float, __builtin_amdgcn_update_dpp(0, __builtin_bit_cast(int, v), 0x110 + SH, 0xf, 0xf, true));
}
__device__ __forceinline__ float scan16(float v) { v += dpp_shr<1>(v); v += dpp_shr<2>(v); v += dpp_shr<4>(v); v += dpp_shr<8>(v); return v; }
__device__ __forceinline__ float clampe(float x) { return fminf(fmaxf(x, -80.f), 80.f); }

struct EpiP1 {
    static constexpr bool PERM = true, AFTER_DRAIN = false;
    unsigned char* ws;
    __device__ __forceinline__ void operator()(const f32x4 (&acc)[2][2][4][2], const Unit& u, int wr, int wc, int fr, int fq) const {
        { int t_ = threadIdx.x; asm volatile("" : "+v"(t_)); fr = t_ & 15; fq = (t_ >> 4) & 3; }
        const int pn = u.pn, lane = fq * 16 + fr;
        bf16_t* const QLAT = (bf16_t*)(ws + WS_QLAT); bf16_t* const KVLAT = (bf16_t*)(ws + WS_KVLAT); bf16_t* const KPE = (bf16_t*)(ws + WS_KPE);
        bf16_t* const QG = (bf16_t*)(ws + WS_QG); bf16_t* const KG = (bf16_t*)(ws + WS_KG);
        float* const SSQQ = (float*)(ws + WS_SSQQ); float* const SSQKV = (float*)(ws + WS_SSQKV); float* const ER = (float*)(ws + WS_ER); float* const EER = (float*)(ws + WS_EER);
        const float* const LB = (const float*)(ws + WS_LB); const f32x2e* const CS = (const f32x2e*)(ws + WS_CS);
        const int rowb = u.pm * BM + wr * 64 + fr, cw = wc * 32 + 8 * fq;
        if (pn == 0) {
#pragma unroll
            for (int ai = 0; ai < 2; ++ai)
#pragma unroll
                for (int m = 0; m < 4; ++m) { const size_t row = (size_t)(rowb + ai * HALF + m * 16); float s = 0.f;
#pragma unroll
                    for (int bj = 0; bj < 2; ++bj) { const f32x4 v0 = acc[ai][bj][m][0], v1 = acc[ai][bj][m][1]; s += sq4(v0) + sq4(v1); st8(QLAT + row * QRANK + bj * HALF + cw, v0, v1); }
                    s += __shfl_xor(s, 16); s += __shfl_xor(s, 32); if (fq == 0) SSQQ[row * 4 + wc] = s; }
        } else if (pn == 1) {
#pragma unroll
            for (int ai = 0; ai < 2; ++ai)
#pragma unroll
                for (int m = 0; m < 4; ++m) { const size_t row = (size_t)(rowb + ai * HALF + m * 16);
                    const f32x4 v0 = acc[ai][0][m][0], v1 = acc[ai][0][m][1]; float s = sq4(v0) + sq4(v1); st8(KVLAT + row * KVRANK + cw, v0, v1);
                    s += __shfl_xor(s, 16); s += __shfl_xor(s, 32); if (fq == 0) SSQKV[row * 4 + wc] = s;
                    if (wc == 0) {
                        const f32x4 x0 = acc[ai][1][m][0], x1 = acc[ai][1][m][1]; f32x4 p0, p1, o0, o1;
#pragma unroll
                        for (int j = 0; j < 4; ++j) { p0[j] = __shfl_xor(x0[j], 32); p1[j] = __shfl_xor(x1[j], 32); }
                        const f32x2e* cs = CS + row * 16 + 8 * (fq & 1); const float sg = (fq < 2) ? -1.f : 1.f;
#pragma unroll
                        for (int j = 0; j < 4; ++j) { const f32x2e c0 = cs[j], c1 = cs[4 + j]; o0[j] = x0[j] * c0.x + sg * p0[j] * c0.y; o1[j] = x1[j] * c1.x + sg * p1[j] * c1.y; }
                        st8(KPE + row * ROPE + 8 * fq, o0, o1);
                    } }
        } else if (pn < 4 || pn >= 8) {
            size_t doff; bool act; int colt;
            if (pn < 4) { doff = WS_GMLA; act = true; colt = (pn - 2) * BM; } else if (pn < 10) { doff = WS_HV; act = false; colt = (pn - 8) * BM; } else { doff = WS_GHG; act = true; colt = (pn - 10) * BM; }
            bf16_t* const dst = (bf16_t*)(ws + doff);
#pragma unroll
            for (int ai = 0; ai < 2; ++ai)
#pragma unroll
                for (int m = 0; m < 4; ++m) { const size_t row = (size_t)(rowb + ai * HALF + m * 16);
#pragma unroll
                    for (int bj = 0; bj < 2; ++bj) { f32x4 v0 = acc[ai][bj][m][0], v1 = acc[ai][bj][m][1]; if (act) { v0 = silu4(v0); v1 = silu4(v1); }
                        st8(dst + row * 512 + colt + bj * HALF + cw, v0, v1); } }
        } else {
            const int ch0 = (pn - 4) * HGD + cw;
#pragma unroll
            for (int ai = 0; ai < 2; ++ai) {
                const int gch = (u.pm * BM + ai * HALF + wr * 64) >> 6;
                f32x4 qo[4][2], ko[4][2];
#pragma unroll
                for (int n = 0; n < 2; ++n)
#pragma unroll
                    for (int j = 0; j < 4; ++j) { const float lb = LB[ch0 + 4 * n + j], oml = 1.f - lb;
                        float g[4], kk[4];
#pragma unroll
                        for (int m = 0; m < 4; ++m) { const float x = acc[ai][1][m][n][j]; const float f = lb + oml * sigm(x); kk[m] = oml * sigm(-x); g[m] = scan16(__logf(f)); }
                        const int l15 = (lane & 48) | 15;
                        const float t0 = __shfl(g[0], l15), t1 = __shfl(g[1], l15), t2 = __shfl(g[2], l15), t3 = __shfl(g[3], l15);
                        g[1] += t0; g[2] += t0 + t1; g[3] += (t0 + t1) + t2;
                        const float R = t0 + t1, Gend = (t0 + t1) + (t2 + t3);
#pragma unroll
                        for (int m = 0; m < 4; ++m) { const float d = clampe(g[m] - R); qo[m][n][j] = silu_f(acc[ai][0][m][n][j]) * __expf(d); ko[m][n][j] = kk[m] * __expf(-d); }
                        if (fr == 15) { ER[(size_t)gch * HGW + ch0 + 4 * n + j] = __expf(clampe(R)); EER[(size_t)gch * HGW + ch0 + 4 * n + j] = __expf(clampe(Gend - R)); }
                    }
#pragma unroll
                for (int m = 0; m < 4; ++m) { const size_t row = (size_t)(rowb + ai * HALF + m * 16); st8(QG + row * HGW + ch0, qo[m][0], qo[m][1]); st8(KG + row * HGW + ch0, ko[m][0], ko[m][1]); }
            }
        }
    }
};

struct EpiQ {
    static constexpr bool PERM = true, AFTER_DRAIN = false;
    bf16_t* Q; const float* SSQQ; const f32x2e* CS;
    __device__ __forceinline__ void operator()(const f32x4 (&acc)[2][2][4][2], const Unit& u, int wr, int wc, int fr, int fq) const {
        { int t_ = threadIdx.x; asm volatile("" : "+v"(t_)); fr = t_ & 15; fq = (t_ >> 4) & 3; }
        const int rowb = u.pm * BM + wr * 64 + fr;
#pragma unroll
        for (int ai = 0; ai < 2; ++ai)
#pragma unroll
            for (int m = 0; m < 4; ++m) { const size_t row = (size_t)(rowb + ai * HALF + m * 16);
                const f32x4 sq = *(const f32x4*)(SSQQ + row * 4); const float rs = rsqrtf(((sq[0] + sq[1]) + (sq[2] + sq[3])) * (1.f / QRANK) + EPS) * QSCALE;
#pragma unroll
                for (int bj = 0; bj < 2; ++bj) { const int g32 = u.pn * 8 + bj * 4 + wc;
                    f32x4 x0 = acc[ai][bj][m][0] * rs, x1 = acc[ai][bj][m][1] * rs;
                    if (g32 % 3 == 2) {
                        f32x4 p0, p1, o0, o1;
#pragma unroll
                        for (int j = 0; j < 4; ++j) { p0[j] = __shfl_xor(x0[j], 32); p1[j] = __shfl_xor(x1[j], 32); }
                        const f32x2e* cs = CS + row * 16 + 8 * (fq & 1); const float sg = (fq < 2) ? -1.f : 1.f;
#pragma unroll
                        for (int j = 0; j < 4; ++j) { const f32x2e c0 = cs[j], c1 = cs[4 + j]; o0[j] = x0[j] * c0.x + sg * p0[j] * c0.y; o1[j] = x1[j] * c1.x + sg * p1[j] * c1.y; }
                        x0 = o0; x1 = o1;
                    }
                    st8(Q + row * NQ + g32 * 32 + 8 * fq, x0, x1); } }
    }
};
struct EpiKV {
    static constexpr bool PERM = true, AFTER_DRAIN = false;
    bf16_t *KN, *V; const float* SSQKV;
    __device__ __forceinline__ void operator()(const f32x4 (&acc)[2][2][4][2], const Unit& u, int wr, int wc, int fr, int fq) const {
        { int t_ = threadIdx.x; asm volatile("" : "+v"(t_)); fr = t_ & 15; fq = (t_ >> 4) & 3; }
        const int rowb = u.pm * BM + wr * 64 + fr;
#pragma unroll
        for (int ai = 0; ai < 2; ++ai)
#pragma unroll
            for (int m = 0; m < 4; ++m) { const size_t row = (size_t)(rowb + ai * HALF + m * 16);
                const f32x4 sq = *(const f32x4*)(SSQKV + row * 4); const float rs = rsqrtf(((sq[0] + sq[1]) + (sq[2] + sq[3])) * (1.f / KVRANK) + EPS);
#pragma unroll
                for (int bj = 0; bj < 2; ++bj) { const int g32 = u.pn * 8 + bj * 4 + wc, h = g32 >> 2, part = g32 & 3;
                    bf16_t* dst = (part < 2 ? KN : V) + row * 512 + h * 64 + (part & 1) * 32 + 8 * fq;
                    st8(dst, acc[ai][bj][m][0] * rs, acc[ai][bj][m][1] * rs); } }
    }
};
struct EpiOut {
    static constexpr bool PERM = false, AFTER_DRAIN = false;
    const float* X; float* OUT; float* SSQO;
    __device__ __forceinline__ void operator()(const f32x4 (&acc)[2][2][4][2], const Unit& u, int wr, int wc, int fr, int fq) const {
        { int t_ = threadIdx.x; asm volatile("" : "+v"(t_)); fr = t_ & 15; fq = (t_ >> 4) & 3; }
        const int rowb = u.pm * BM + wr * 64 + fr, col0 = u.pn * BM + wc * 32 + 4 * fq;
#pragma unroll
        for (int ai = 0; ai < 2; ++ai)
#pragma unroll
            for (int m = 0; m < 4; ++m) { const size_t off = (size_t)(rowb + ai * HALF + m * 16) * DMODEL + col0; float s = 0.f;
#pragma unroll
                for (int bj = 0; bj < 2; ++bj)
#pragma unroll
                    for (int n = 0; n < 2; ++n) { const f32x4 v = acc[ai][bj][m][n] + *(const f32x4*)(X + off + bj * HALF + n * 16); s += sq4(v); *(f32x4*)(OUT + off + bj * HALF + n * 16) = v; }
                s += __shfl_xor(s, 16); s += __shfl_xor(s, 32); if (fq == 0) SSQO[(size_t)(rowb + ai * HALF + m * 16) * 16 + u.pn * 4 + wc] = s; }
    }
};
template <class Epi, class Sched, bool ALIGN_EPI = false, bool SP2 = false>
__device__ __forceinline__ void gemm_phase(PG8_LAS unsigned char* lds, const Gemm g, const Sched& S, const Epi& E) {
    int tid_ = threadIdx.x; asm volatile("" : "+v"(tid_));
    const int tid = tid_, wid = __builtin_amdgcn_readfirstlane(tid >> 6), lane = tid & 63, wr = wid >> 2, wc = wid & 3, fr = lane & 15, fq = lane >> 4;
    const int K = g.K, nt = K / BK;
    unsigned voffA[2], voffB[2];
#pragma unroll
    for (int i = 0; i < 2; ++i) { int R, C; stage_rc(tid * 16 + i * 8192, R, C); const int Rb = Epi::PERM ? ((R & ~31) + perm32(R & 31)) : R;
        voffA[i] = (unsigned)(R * K + C) * 2u; voffB[i] = (unsigned)(Rb * K + C) * 2u; }
    const size_t kstep = (size_t)(BK * 2);
    const size_t hstep = (size_t)HALF * K * 2;
    const size_t tstep = 2 * hstep;
    const unsigned ldsw = (unsigned)wid * 1024u;
    const int aoff = lds_byte(wr * 64 + fr, fq * 8), boff = lds_byte(wc * 32 + fr, fq * 8);
#define PG8_SA(b, h) (((b) * 2 + (h)) * HTB)
#define PG8_SB(b, h) ((4 + (b) * 2 + (h)) * HTB)
#define PG8_STAGE(bufoff, gbase, voff) do { _Pragma("unroll") for (int _i = 0; _i < 2; ++_i) \
        __builtin_amdgcn_global_load_lds((const unsigned*)((const char*)(gbase) + (voff)[_i]), (PG8_LAS unsigned*)(lds + (bufoff) + ldsw + _i * 8192), 16, 0, 0); } while (0)
#define PG8_LDA(dst, b, h) do { _Pragma("unroll") for (int m = 0; m < 4; ++m) _Pragma("unroll") for (int k = 0; k < 2; ++k) dst[m][k] = *(const PG8_LAS bf16x8*)(lds + PG8_SA(b, h) + aoff + m * 2048 + k * 1024); } while (0)
#define PG8_LDB(dst, b, h) do { _Pragma("unroll") for (int n = 0; n < 2; ++n) _Pragma("unroll") for (int k = 0; k < 2; ++k) dst[n][k] = *(const PG8_LAS bf16x8*)(lds + PG8_SB(b, h) + boff + n * 2048 + k * 1024); } while (0)
#define PG8_MMA(ai, bj, At, Bt) do { __builtin_amdgcn_s_setprio(1); _Pragma("unroll") for (int m = 0; m < 4; ++m) _Pragma("unroll") for (int n = 0; n < 2; ++n) _Pragma("unroll") for (int k = 0; k < 2; ++k) \
        acc[ai][bj][m][n] = __builtin_amdgcn_mfma_f32_16x16x32_bf16(Bt[n][k], At[m][k], acc[ai][bj][m][n], 0, 0, 0); __builtin_amdgcn_s_setprio(0); } while (0)
#define PG8_WAIT_V(n) asm volatile("s_waitcnt vmcnt(" #n ")" ::: "memory")
#define PG8_WAIT_L(n) asm volatile("s_waitcnt lgkmcnt(" #n ")" ::: "memory")
#define PG8_BAR __builtin_amdgcn_s_barrier()
#define PG8_SCHED __builtin_amdgcn_sched_barrier(0)
    Unit cur, nxt; int ui = 0;
    if (!S.next(0, cur)) return;
    f32x4 acc[2][2][4][2];
#pragma unroll
    for (int a = 0; a < 2; ++a)
#pragma unroll
        for (int b = 0; b < 2; ++b)
#pragma unroll
            for (int m = 0; m < 4; ++m)
#pragma unroll
                for (int n = 0; n < 2; ++n) acc[a][b][m][n] = (f32x4){0.f, 0.f, 0.f, 0.f};
    bf16x8 At[4][2], B0[2][2], B1[2][2];
    const char* cA = (const char*)g.A + (size_t)cur.pm * tstep; const char* cB = (const char*)g.Bt + (size_t)cur.pn * tstep;
    S.a_ready(cur);
    if constexpr (SP2) {
        PG8_STAGE(PG8_SB(0, 0), cB, voffB); PG8_STAGE(PG8_SB(0, 1), cB + hstep, voffB); PG8_STAGE(PG8_SA(0, 0), cA, voffA); PG8_STAGE(PG8_SA(0, 1), cA + hstep, voffA);
        if (wr == 1) PG8_BAR;
        PG8_WAIT_V(2); PG8_BAR;
        PG8_STAGE(PG8_SB(1, 0), cB + kstep, voffB); PG8_STAGE(PG8_SA(1, 0), cA + kstep, voffA); PG8_STAGE(PG8_SB(1, 1), cB + hstep + kstep, voffB);
        PG8_WAIT_V(6); PG8_BAR;
    } else {
        PG8_STAGE(PG8_SB(0, 0), cB, voffB); PG8_STAGE(PG8_SA(0, 0), cA, voffA); PG8_STAGE(PG8_SB(0, 1), cB + hstep, voffB); PG8_STAGE(PG8_SA(0, 1), cA + hstep, voffA);
        if (wr == 1) PG8_BAR;
        PG8_WAIT_V(4); PG8_BAR;
        PG8_STAGE(PG8_SB(1, 0), cB + kstep, voffB); PG8_STAGE(PG8_SA(1, 0), cA + kstep, voffA); PG8_STAGE(PG8_SB(1, 1), cB + hstep + kstep, voffB);
        PG8_WAIT_V(6); PG8_BAR;
    }
    for (;;) {
        const bool has_next = S.next(ui + 1, nxt);
        const char* nA = has_next ? (const char*)g.A + (size_t)nxt.pm * tstep : cA; const char* nB = has_next ? (const char*)g.Bt + (size_t)nxt.pn * tstep : cB;
        for (int t = 0; t < nt; t += 2) {
            const bool last = (t == nt - 2);
            const char* a1 = cA + (size_t)(t + 1) * kstep;
            const char* a2 = last ? nA : cA + (size_t)(t + 2) * kstep; const char* b2 = last ? nB : cB + (size_t)(t + 2) * kstep;
            const char* a3 = a2 + kstep; const char* b3 = b2 + kstep;
            if (last && has_next) S.a_ready(nxt);
            if constexpr (SP2) {
            PG8_LDB(B0, 0, 0); PG8_LDB(B1, 0, 1); PG8_SCHED; PG8_LDA(At, 0, 0); PG8_STAGE(PG8_SA(1, 1), a1 + hstep, voffA);
            PG8_WAIT_V(8); PG8_WAIT_L(0); PG8_BAR; PG8_MMA(0, 0, At, B0); PG8_MMA(0, 1, At, B1); PG8_BAR; PG8_SCHED;
            PG8_LDA(At, 0, 1); PG8_STAGE(PG8_SB(0, 0), b2, voffB); PG8_STAGE(PG8_SB(0, 1), b2 + hstep, voffB); PG8_STAGE(PG8_SA(0, 0), a2, voffA);
            PG8_WAIT_V(8); PG8_WAIT_L(0); PG8_BAR; PG8_MMA(1, 0, At, B0); PG8_MMA(1, 1, At, B1); PG8_BAR; PG8_SCHED;
            PG8_LDB(B0, 1, 0); PG8_LDB(B1, 1, 1); PG8_SCHED; PG8_LDA(At, 1, 0); PG8_STAGE(PG8_SA(0, 1), a2 + hstep, voffA);
            PG8_WAIT_V(8); PG8_WAIT_L(0); PG8_BAR; PG8_MMA(0, 0, At, B0); PG8_MMA(0, 1, At, B1); PG8_BAR; PG8_SCHED;
            PG8_LDA(At, 1, 1); PG8_STAGE(PG8_SB(1, 0), b3, voffB); PG8_STAGE(PG8_SB(1, 1), b3 + hstep, voffB); PG8_STAGE(PG8_SA(1, 0), a3, voffA);
            PG8_WAIT_V(8); PG8_WAIT_L(0); PG8_BAR; PG8_MMA(1, 0, At, B0); PG8_MMA(1, 1, At, B1); PG8_BAR; PG8_SCHED;
            } else {
            PG8_LDB(B0, 0, 0); PG8_SCHED; PG8_LDA(At, 0, 0); PG8_STAGE(PG8_SA(1, 1), a1 + hstep, voffA);
            PG8_WAIT_L(8); PG8_BAR; PG8_WAIT_L(0); PG8_MMA(0, 0, At, B0); PG8_BAR; PG8_SCHED;
            PG8_LDB(B1, 0, 1); PG8_STAGE(PG8_SB(0, 0), b2, voffB);
            PG8_BAR; PG8_WAIT_L(0); PG8_MMA(0, 1, At, B1); PG8_BAR;
            PG8_LDA(At, 0, 1); PG8_STAGE(PG8_SA(0, 0), a2, voffA);
            PG8_BAR; PG8_WAIT_L(0); PG8_MMA(1, 0, At, B0); PG8_BAR; PG8_SCHED;
            PG8_STAGE(PG8_SB(0, 1), b2 + hstep, voffB);
            PG8_WAIT_V(6); PG8_BAR; PG8_MMA(1, 1, At, B1); PG8_BAR;
            PG8_LDB(B0, 1, 0); PG8_SCHED; PG8_LDA(At, 1, 0); PG8_STAGE(PG8_SA(0, 1), a2 + hstep, voffA);
            PG8_WAIT_L(8); PG8_BAR; PG8_WAIT_L(0); PG8_MMA(0, 0, At, B0); PG8_BAR; PG8_SCHED;
            PG8_LDB(B1, 1, 1); PG8_STAGE(PG8_SB(1, 0), b3, voffB);
            PG8_BAR; PG8_WAIT_L(0); PG8_MMA(0, 1, At, B1); PG8_BAR;
            PG8_LDA(At, 1, 1); PG8_STAGE(PG8_SA(1, 0), a3, voffA);
            PG8_BAR; PG8_WAIT_L(0); PG8_MMA(1, 0, At, B0); PG8_BAR; PG8_SCHED;
            PG8_STAGE(PG8_SB(1, 1), b3 + hstep, voffB);
            PG8_WAIT_V(6); PG8_BAR; PG8_MMA(1, 1, At, B1); PG8_BAR;
            }
        }
        if constexpr (ALIGN_EPI) { if (wr == 0) PG8_BAR; }
        if constexpr (!Epi::AFTER_DRAIN) { E(acc, cur, wr, wc, fr, fq); S.done(cur); }
        if (!has_next) break;
#pragma unroll
        for (int a = 0; a < 2; ++a)
#pragma unroll
            for (int b = 0; b < 2; ++b)
#pragma unroll
                for (int m = 0; m < 4; ++m)
#pragma unroll
                    for (int n = 0; n < 2; ++n) acc[a][b][m][n] = (f32x4){0.f, 0.f, 0.f, 0.f};
        cur = nxt; cA = nA; cB = nB; ++ui;
        if constexpr (ALIGN_EPI) { if (wr == 1) PG8_BAR; }
    }
    PG8_WAIT_V(0);
    if constexpr (!ALIGN_EPI) { if (wr == 0) PG8_BAR; }
    PG8_BAR;
    if constexpr (Epi::AFTER_DRAIN) { E.fused(acc, cur, wr, wc, fr, fq, lds, wid, lane); S.done(cur); }
#undef PG8_SA
#undef PG8_SB
#undef PG8_STAGE
#undef PG8_LDA
#undef PG8_LDB
#undef PG8_MMA
#undef PG8_WAIT_V
#undef PG8_WAIT_L
#undef PG8_BAR
#undef PG8_SCHED
}
}

#ifndef PG8_SP2
#define PG8_SP2 true
#endif
#define GAS __attribute__((address_space(1)))
#define LAS __attribute__((address_space(3)))
typedef unsigned short bf16;
typedef unsigned v4u __attribute__((ext_vector_type(4)));
typedef float f32x4 __attribute__((ext_vector_type(4)));
typedef short bf16x8 __attribute__((ext_vector_type(8)));
typedef GAS unsigned gu32;
typedef GAS unsigned long long gu64;
#define RLX_AGENT __ATOMIC_RELAXED, __HIP_MEMORY_SCOPE_AGENT
#define LDS_WAIT() asm volatile("s_waitcnt lgkmcnt(0)" ::: "memory")
#define VM_WAIT() asm volatile("s_waitcnt vmcnt(0)" ::: "memory")
__device__ __forceinline__ unsigned long long rt() { return __builtin_amdgcn_s_memrealtime(); }
__device__ __forceinline__ unsigned f2bf(float f) { unsigned u = __builtin_bit_cast(unsigned, f); return (u + 0x7fffu + ((u >> 16) & 1u)) >> 16; }
__device__ __forceinline__ unsigned pk2(float lo, float hi) { return f2bf(lo) | (f2bf(hi) << 16); }
#define XB_TMO      128
#define XB_XCNT(j)  (256  + 64 * (j))
#define XB_XSUB(j)  (1280 + 64 * (j))
#define XB_XGEN(j)  (2304 + 64 * (j))
#define XB_TOP      3328
#define XB_TOPGEN   3392
#define XCD_BAR_WORDS 3456
#define XB_SPIN_CAP (1u << 18)

__device__ __forceinline__ unsigned xb_ld(unsigned* p)              { return __hip_atomic_load(p, __ATOMIC_RELAXED, __HIP_MEMORY_SCOPE_AGENT); }
__device__ __forceinline__ unsigned xb_add(unsigned* p, unsigned v) { return __hip_atomic_fetch_add(p, v, __ATOMIC_RELAXED, __HIP_MEMORY_SCOPE_AGENT); }
__device__ __forceinline__ unsigned xb_xcc_id() { return (unsigned)__builtin_amdgcn_s_getreg((3 << 11) | 20) & 0xFu; }
#define XB_SPIN(cond, bar) do { unsigned _sp = 0; while (cond) { __builtin_amdgcn_s_sleep(1); \
    if ((++_sp & 255u) == 0u) { if (xb_ld(&(bar)[XB_TMO])) break; if (_sp > XB_SPIN_CAP) { atomicAdd(&(bar)[XB_TMO], 1u); break; } } } } while (0)

struct XcdBarrier {
    unsigned* bar; unsigned x;
    volatile LAS unsigned* st;
};

__device__ __forceinline__ XcdBarrier xcd_barrier_post(unsigned* bar, volatile LAS unsigned* st) {
    XcdBarrier b; b.bar = bar; b.x = xb_xcc_id(); b.st = st;
    if (threadIdx.x == 0) (void)xb_add(&bar[XB_XCNT(b.x)], 1u);
    return b;
}
__device__ __forceinline__ void xcd_barrier_complete(unsigned* bar, unsigned x, unsigned& nloc, unsigned& nx) {
    const unsigned G = gridDim.x * gridDim.y * gridDim.z;
    unsigned sum, cnt, mine, sp = 0u;
    for (;;) {
        sum = 0u; cnt = 0u; mine = 0u;
#pragma unroll
        for (unsigned j = 0; j < 16; ++j) { const unsigned c = xb_ld(&bar[XB_XCNT(j)]); sum += c; cnt += (c > 0u) ? 1u : 0u; mine = (j == x) ? c : mine; }
        if (sum == G) break;
        __builtin_amdgcn_s_sleep(1);
        if ((++sp & 255u) == 0u) { if (xb_ld(&bar[XB_TMO])) break; if (sp > XB_SPIN_CAP) { atomicAdd(&bar[XB_TMO], 1u); break; } }
    }
    nloc = mine > 0u ? mine : 1u; nx = cnt > 0u ? cnt : 1u;
}

__device__ __forceinline__ void xcd_barrier(const XcdBarrier& b) {
    asm volatile("s_waitcnt vmcnt(0)" ::: "memory");
    __syncthreads();
    if (threadIdx.x == 0) {
        unsigned* bar = b.bar;
        __builtin_amdgcn_s_waitcnt(0);
        unsigned nloc = b.st[0], nx = b.st[1];
        if (nloc == 0u) { xcd_barrier_complete(bar, b.x, nloc, nx); b.st[0] = nloc; b.st[1] = nx; }
        const unsigned old = xb_add(&bar[XB_XSUB(b.x)], 1u);
        const unsigned gen = old / nloc;
        if (old + 1u == (gen + 1u) * nloc) {
            __builtin_amdgcn_fence(__ATOMIC_RELEASE, "agent");
            asm volatile("s_waitcnt vmcnt(0)" ::: "memory");
            const unsigned og = xb_add(&bar[XB_TOP], 1u);
            const unsigned tg = og / nx;
            if (og + 1u == (tg + 1u) * nx) xb_add(&bar[XB_TOPGEN], 1u);
            else XB_SPIN(xb_ld(&bar[XB_TOPGEN]) == tg, bar);
            __builtin_amdgcn_fence(__ATOMIC_ACQUIRE, "agent");
            xb_add(&bar[XB_XGEN(b.x)], 1u);
            asm volatile("s_waitcnt vmcnt(0)" ::: "memory");
        } else {
            XB_SPIN(xb_ld(&bar[XB_XGEN(b.x)]) == gen, bar);
            __builtin_amdgcn_fence(__ATOMIC_ACQUIRE, "agent");
            asm volatile("s_waitcnt vmcnt(0)" ::: "memory");
        }
    }
    __syncthreads();
}

constexpr int NWAVES = 8, NTHREADS = 512;
constexpr int RING_BYTES = 131072, LDSCTL_OFF = RING_BYTES, MISC_OFF = LDSCTL_OFF + 320, LDS_BYTES = 147456;

struct Args { const float* x; const int* pos; const float *ln_g, *w_in, *qn_g, *w_q_b, *kvn_g, *w_kv_b, *hg_lb, *hg_ng, *w_out, *fn_g; float* out; unsigned char* ws; int ph_lo, ph_hi; };

__device__ __forceinline__ float wave_sum(float v) {
#pragma unroll
    for (int o = 1; o < 64; o <<= 1) v += __shfl_xor(v, o);
    return v;
}
__device__ __forceinline__ int tid_opaque() { int t = threadIdx.x; asm volatile("" : "+v"(t)); return t; }
__device__ __forceinline__ float bf2f(bf16 b) { return __builtin_bit_cast(float, (unsigned)b << 16); }

__device__ const double INV_FREQ[16] = {1.0, 0.5623413251903491, 0.31622776601683794, 0.1778279410038923, 0.1, 0.05623413251903491, 0.03162277660168379, 0.01778279410038923,
                                        0.01, 0.005623413251903491, 0.0031622776601683794, 0.0017782794100389228, 0.001, 0.0005623413251903491, 0.00031622776601683794, 0.00017782794100389227};
__device__ __forceinline__ void p0_transpose_item(const float* W, int ldw, const float* kscale, bf16* WT, int ldt, int k0, int src_n0, int dst_n0, LAS float* scr, int lane) {
#pragma unroll 8
    for (int i = 0; i < 32; ++i) { const int kk = 2 * i + (lane >> 5); float v = 0.f;
        if (src_n0 >= 0) { v = W[(size_t)(k0 + kk) * ldw + src_n0 + (lane & 31)]; if (kscale) v *= kscale[k0 + kk]; }
        scr[kk * 33 + (lane & 31)] = v; }
    LDS_WAIT(); asm volatile("" ::: "memory");
    const int c = lane & 7;
#pragma unroll
    for (int j = 0; j < 4; ++j) { const int n = (lane >> 3) + 8 * j; const LAS float* s = scr + (8 * c) * 33 + n;
        v4u o; o.x = pk2(s[0 * 33], s[1 * 33]); o.y = pk2(s[2 * 33], s[3 * 33]); o.z = pk2(s[4 * 33], s[5 * 33]); o.w = pk2(s[6 * 33], s[7 * 33]);
        *(GAS v4u*)(WT + (size_t)(dst_n0 + n) * ldt + k0 + 8 * c) = o; }
    LDS_WAIT(); asm volatile("" ::: "memory");
}
__device__ __forceinline__ int w1_src_col(int n0) {
    if (n0 < 416) return n0;
    if (n0 < 512) return -1;
    if (n0 < 1024) return C_GMLA + (n0 - 512);
    if (n0 < 2048) { const int h = (n0 - 1024) >> 8, w = (n0 - 1024) & 255; return w < 128 ? C_HQ + 128 * h + w : C_HF + 128 * h + (w - 128); }
    if (n0 < 2560) return C_HI + (n0 - 2048);
    return C_GHG + (n0 - 2560);
}
__device__ __forceinline__ void p0_prologue(const Args& a, LAS unsigned char* lds, int vcu, int G) {
    const int tid = tid_opaque(), lane = tid & 63, wave = __builtin_amdgcn_readfirstlane(tid >> 6);
    unsigned char* ws = a.ws;
    LAS float* scr = (LAS float*)(lds + wave * 16384);
    const int gw = vcu * NWAVES + wave, NGW = G * NWAVES;
    constexpr int I_1 = (DMODEL / 64) * (N1 / 32), I_Q = (QRANK / 64) * (NQ / 32), I_KV = (KVRANK / 64) * (NKV / 32), I_O = (DMODEL / 64) * (DMODEL / 32);
    for (int it = gw; it < I_1 + I_Q + I_KV + I_O; it += NGW) {
        int r = it;
        if (r < I_1) { const int nb = r % (N1 / 32), kb = r / (N1 / 32); p0_transpose_item(a.w_in, D_IN, nullptr, (bf16*)(ws + WS_W1T), DMODEL, 64 * kb, w1_src_col(32 * nb), 32 * nb, scr, lane); continue; } r -= I_1;
        if (r < I_Q) { const int nb = r % (NQ / 32), kb = r / (NQ / 32); p0_transpose_item(a.w_q_b, NQ, a.qn_g, (bf16*)(ws + WS_WQT), QRANK, 64 * kb, 32 * nb, 32 * nb, scr, lane); continue; } r -= I_Q;
        if (r < I_KV) { const int nb = r % (NKV / 32), kb = r / (NKV / 32); p0_transpose_item(a.w_kv_b, NKV, a.kvn_g, (bf16*)(ws + WS_WKVT), KVRANK, 64 * kb, 32 * nb, 32 * nb, scr, lane); continue; } r -= I_KV;
        { const int nb = r % (DMODEL / 32), kb = r / (DMODEL / 32); p0_transpose_item(a.w_out, DMODEL, nullptr, (bf16*)(ws + WS_WOT), DMODEL, 64 * kb, 32 * nb, 32 * nb, scr, lane); }
    }
    f32x4 gv[4];
#pragma unroll
    for (int j = 0; j < 4; ++j) gv[j] = *((const f32x4*)a.ln_g + lane + 64 * j);
    for (int m = gw; m < MTOK; m += NGW) {
        const GAS f32x4* xr = (const GAS f32x4*)(a.x + (size_t)m * DMODEL) + lane;
        f32x4 v[4]; float s = 0.f;
#pragma unroll
        for (int j = 0; j < 4; ++j) { v[j] = xr[64 * j]; s += (v[j].x * v[j].x + v[j].y * v[j].y) + (v[j].z * v[j].z + v[j].w * v[j].w); }
        const float rstd = rsqrtf(wave_sum(s) * (1.f / DMODEL) + EPS);
        GAS unsigned long long* o8 = (GAS unsigned long long*)((bf16*)(ws + WS_XN) + (size_t)m * DMODEL) + lane;
#pragma unroll
        for (int j = 0; j < 4; ++j) { const f32x4 y = v[j] * rstd * gv[j]; o8[64 * j] = (unsigned long long)pk2(y.x, y.y) | ((unsigned long long)pk2(y.z, y.w) << 32); }
    }
    { const int gt = vcu * NTHREADS + wave * 64 + lane, NGT = G * NTHREADS;
      float2* cs = (float2*)(ws + WS_CS);
      for (int e = gt; e < MTOK * 16; e += NGT) { const int m = e >> 4, i = e & 15;
          double r = (double)a.pos[m] * INV_FREQ[i] * 0.15915494309189535; r -= floor(r);
          const float rf = (float)r; cs[e] = make_float2(__builtin_amdgcn_cosf(rf), __builtin_amdgcn_sinf(rf)); }
      if (gt < HGW) { const float a0 = a.hg_lb[gt], a1 = a.hg_lb[HGW + gt]; ((float*)(ws + WS_LB))[gt] = 1.f / (1.f + expf(a1 - a0)); }
    }
}

__device__ __forceinline__ void naive_attn_unit(int unit, const Args& a, LAS unsigned char* lds) {
    const int tid = tid_opaque();
    unsigned char* ws = a.ws;
    const bf16* Q = (const bf16*)(ws + WS_Q); const bf16* KN = (const bf16*)(ws + WS_KN); const bf16* KPE = (const bf16*)(ws + WS_KPE); const bf16* V = (const bf16*)(ws + WS_V);
    const bf16* GM = (const bf16*)(ws + WS_GMLA); bf16* Y = (bf16*)(ws + WS_Y);
    const int qb = unit & 7, h = (unit >> 3) & 7, b = unit >> 6;
    LAS float* Ks = (LAS float*)lds; LAS float* Vs = Ks + 64 * QHD;
    const int qrow = qb * 512 + tid; const size_t grow = (size_t)b * SEQ + qrow;
    float q[QHD], o[VDIM];
#pragma unroll
    for (int d = 0; d < QHD; ++d) q[d] = bf2f(Q[grow * NQ + h * QHD + d]);
#pragma unroll
    for (int d = 0; d < VDIM; ++d) o[d] = 0.f;
    float mx = -1e30f, l = 0.f;
    const int nt = (qb * 512 + 512) / 64;
    for (int j = 0; j < nt; ++j) {
        __syncthreads();
        for (int idx = tid; idx < 64 * QHD; idx += NTHREADS) { const int key = idx / QHD, d = idx % QHD; const size_t kr = (size_t)b * SEQ + 64 * j + key;
            Ks[idx] = d < NOPE ? bf2f(KN[kr * 512 + h * NOPE + d]) : bf2f(KPE[kr * ROPE + (d - NOPE)]); }
        for (int idx = tid; idx < 64 * VDIM; idx += NTHREADS) { const int key = idx / VDIM, d = idx % VDIM; Vs[idx] = bf2f(V[((size_t)b * SEQ + 64 * j + key) * 512 + h * VDIM + d]); }
        __syncthreads();
        for (int key = 0; key < 64; ++key) {
            if (64 * j + key <= qrow) {
                float s = 0.f;
#pragma unroll
                for (int d = 0; d < QHD; ++d) s += q[d] * Ks[key * QHD + d];
                if (s > mx) { const float al = exp2f(mx - s); l *= al;
#pragma unroll
                    for (int d = 0; d < VDIM; ++d) o[d] *= al;
                    mx = s; }
                const float p = exp2f(s - mx); l += p;
#pragma unroll
                for (int d = 0; d < VDIM; ++d) o[d] += p * Vs[key * VDIM + d];
            }
        }
    }
    const float rl = 1.f / l;
#pragma unroll
    for (int d = 0; d < VDIM; d += 2) { const float y0 = o[d] * rl * bf2f(GM[grow * 512 + h * VDIM + d]), y1 = o[d + 1] * rl * bf2f(GM[grow * 512 + h * VDIM + d + 1]);
        *(unsigned*)(Y + grow * DMODEL + h * VDIM + d) = pk2(y0, y1); }
    __syncthreads();
}
__device__ __forceinline__ void naive_scan_unit(int unit, const Args& a, LAS unsigned char* lds) {
    const int tid = tid_opaque();
    unsigned char* ws = a.ws;
    const bf16* QG = (const bf16*)(ws + WS_QG); const bf16* KG = (const bf16*)(ws + WS_KG); const bf16* HV = (const bf16*)(ws + WS_HV);
    const float* ER = (const float*)(ws + WS_ER); const float* EER = (const float*)(ws + WS_EER); float* OS = (float*)(ws + WS_OS);
    const int h = unit & 3, b = unit >> 2;
    LAS float* kgs = (LAS float*)lds; LAS float* qgs = kgs + 128; LAS float* vs = qgs + 128; LAS float* part = vs + 128; LAS float* ers = part + 512; LAS float* eers = ers + 128;
    const int v = tid & 127, kq = tid >> 7;
    float S[32];
#pragma unroll
    for (int i = 0; i < 32; ++i) S[i] = 0.f;
    for (int c = 0; c < NCHUNK; ++c) {
        const size_t gch = (size_t)b * NCHUNK + c;
        __syncthreads();
        if (tid < 128) ers[tid] = ER[gch * HGW + h * HGD + tid]; else if (tid < 256) eers[tid - 128] = EER[gch * HGW + h * HGD + tid - 128];
        __syncthreads();
#pragma unroll
        for (int i = 0; i < 32; ++i) S[i] *= ers[kq * 32 + i];
        for (int t = 0; t < CHUNK; ++t) {
            const size_t row = (size_t)b * SEQ + c * CHUNK + t;
            if (tid < 128) kgs[tid] = bf2f(KG[row * HGW + h * HGD + tid]); else if (tid < 256) qgs[tid - 128] = bf2f(QG[row * HGW + h * HGD + tid - 128]); else if (tid < 384) vs[tid - 256] = bf2f(HV[row * HGW + h * HGD + tid - 256]);
            __syncthreads();
            const float vv = vs[v]; float po = 0.f;
#pragma unroll
            for (int i = 0; i < 32; ++i) { S[i] += kgs[kq * 32 + i] * vv; po += S[i] * qgs[kq * 32 + i]; }
            part[kq * 128 + v] = po;
            __syncthreads();
            if (tid < 128) OS[row * HGW + h * HGD + tid] = (part[tid] + part[128 + tid]) + (part[256 + tid] + part[384 + tid]);
        }
#pragma unroll
        for (int i = 0; i < 32; ++i) S[i] *= eers[kq * 32 + i];
    }
    __syncthreads();
}
__device__ __forceinline__ void scan_norm_phase(const Args& a, int vcu, int G) {
    const int tid = tid_opaque(), lane = tid & 63, wave = __builtin_amdgcn_readfirstlane(tid >> 6);
    unsigned char* ws = a.ws; const float* OS = (const float*)(ws + WS_OS); const bf16* GH = (const bf16*)(ws + WS_GHG); bf16* Y = (bf16*)(ws + WS_Y);
    const int gw = vcu * NWAVES + wave, NGW = G * NWAVES;
    for (int idx = gw; idx < MTOK * HGH; idx += NGW) { const size_t row = idx >> 2; const int h = idx & 3, c = h * HGD + 2 * lane;
        const float2 o = *(const float2*)(OS + row * HGW + c); const float rstd = rsqrtf(wave_sum(o.x * o.x + o.y * o.y) * (1.f / HGD) + EPS);
        const unsigned gg = *(const unsigned*)(GH + row * HGW + c);
        const float y0 = o.x * rstd * a.hg_ng[c] * bf2f((bf16)(gg & 0xffffu)), y1 = o.y * rstd * a.hg_ng[c + 1] * bf2f((bf16)(gg >> 16));
        *(unsigned*)(Y + row * DMODEL + MLAW + c) = pk2(y0, y1); }
}
__device__ __forceinline__ void final_norm_phase(const Args& a, int vcu, int G) {
    const int tid = tid_opaque(), lane = tid & 63, wave = __builtin_amdgcn_readfirstlane(tid >> 6);
    const float* SSQO = (const float*)(a.ws + WS_SSQO);
    const int gw = vcu * NWAVES + wave, NGW = G * NWAVES;
    f32x4 gv[4];
#pragma unroll
    for (int j = 0; j < 4; ++j) gv[j] = *((const f32x4*)a.fn_g + lane + 64 * j);
    for (int m = gw; m < MTOK; m += NGW) {
        float s = (lane < 16) ? SSQO[(size_t)m * 16 + lane] : 0.f; s = wave_sum(s);
        const float rstd = rsqrtf(s * (1.f / DMODEL) + EPS);
        GAS f32x4* orow = (GAS f32x4*)(a.out + (size_t)m * DMODEL) + lane;
#pragma unroll
        for (int j = 0; j < 4; ++j) { const f32x4 v = orow[64 * j]; orow[64 * j] = v * rstd * gv[j]; }
    }
}

#ifndef MK_PER_PHASE
#define MK_PER_PHASE 1
#endif
constexpr int N_PHASES = 7;
__global__ void __launch_bounds__(NTHREADS, 2) hyb_fwd(Args a) {
    extern __shared__ __attribute__((aligned(16))) unsigned char lds_raw[];
    LAS unsigned char* lds = (LAS unsigned char*)lds_raw;
    const int G = gridDim.x; const int bx = blockIdx.x; const int vcu = (G % 8 == 0) ? (bx % 8) * (G / 8) + bx / 8 : bx;
    unsigned char* ws = a.ws;
    gu32* ctl = (gu32*)(ws + WS_CTL);
    volatile LAS unsigned* MISC = (volatile LAS unsigned*)(lds + MISC_OFF);
    for (int u = threadIdx.x; u < (LDS_BYTES - LDSCTL_OFF) / 4; u += NTHREADS) ((LAS unsigned*)(lds + LDSCTL_OFF))[u] = 0u;
    __syncthreads();
    const int lo = a.ph_lo, hi = a.ph_hi;
    const bool fusedl = (hi - lo) > 1;
    XcdBarrier bar; bar.bar = (unsigned*)(ctl + CW_BAR); bar.x = 0; bar.st = nullptr;
    if (fusedl) bar = xcd_barrier_post((unsigned*)(ctl + CW_BAR), MISC + 8);
#define IN(k) (lo <= (k) && (k) < hi)
#define SEAM(k) do { if (IN(k) && IN((k) + 1)) xcd_barrier(bar); } while (0)

#ifndef NO_P0
    if (IN(0)) { p0_prologue(a, lds, vcu, G); SEAM(0); }
#endif

#ifndef NO_P1
    if (IN(1)) {
        pg8::Gemm g{(const bf16*)(ws + WS_XN), (const bf16*)(ws + WS_W1T), MTOK, N1, DMODEL}; pg8::StaticOrder S; S.init(MTOK, N1, G, bx);
        pg8::EpiP1 E{ws};
        pg8::gemm_phase<pg8::EpiP1, pg8::StaticOrder, true, PG8_SP2>(lds, g, S, E);
        SEAM(1);
    }
#endif
#ifndef NO_P2
    if (IN(2)) {
        { pg8::Gemm g{(const bf16*)(ws + WS_QLAT), (const bf16*)(ws + WS_WQT), MTOK, NQ, QRANK}; pg8::StaticOrder S; S.init(MTOK, NQ, G, bx);
          pg8::EpiQ E{(bf16*)(ws + WS_Q), (const float*)(ws + WS_SSQQ), (const pg8::f32x2e*)(ws + WS_CS)};
          pg8::gemm_phase<pg8::EpiQ, pg8::StaticOrder, true, PG8_SP2>(lds, g, S, E); }
        { pg8::Gemm g{(const bf16*)(ws + WS_KVLAT), (const bf16*)(ws + WS_WKVT), MTOK, NKV, KVRANK}; pg8::StaticOrder S; S.init(MTOK, NKV, G, bx);
          pg8::EpiKV E{(bf16*)(ws + WS_KN), (bf16*)(ws + WS_V), (const float*)(ws + WS_SSQKV)};
          pg8::gemm_phase<pg8::EpiKV, pg8::StaticOrder, true, PG8_SP2>(lds, g, S, E); }
        SEAM(2);
    }
#endif
#ifndef NO_P3
    if (IN(3)) {
        if (bx < BATCH * HGH) naive_scan_unit(bx, a, lds);
        for (int u = bx; u < BATCH * NHEAD * (SEQ / 512); u += G) naive_attn_unit(u, a, lds);
        SEAM(3);
    }
#endif
    if (IN(4)) { scan_norm_phase(a, vcu, G); SEAM(4); }
#ifndef NO_P5
    if (IN(5)) {
        pg8::Gemm g{(const bf16*)(ws + WS_Y), (const bf16*)(ws + WS_WOT), MTOK, DMODEL, DMODEL}; pg8::StaticOrder S; S.init(MTOK, DMODEL, G, bx);
        pg8::EpiOut E{a.x, a.out, (float*)(ws + WS_SSQO)};
        pg8::gemm_phase<pg8::EpiOut, pg8::StaticOrder, true, PG8_SP2>(lds, g, S, E);
        SEAM(5);
    }
#endif
    if (IN(6)) final_norm_phase(a, vcu, G);
#undef IN
#undef SEAM
}

extern "C" void kernel_launch(void* const* d_in, const int* in_sizes, int n_in, void* d_out, int out_size, void* d_ws, size_t ws_size, hipStream_t stream) {
    static int grid = 0;
    if (grid == 0) {
        if (n_in != 12 || in_sizes[0] != MTOK * DMODEL || out_size != MTOK * DMODEL || ws_size < WS_END) { fprintf(stderr, "kernel_launch: unexpected shapes (n_in %d, in0 %d, out %d, ws %zu); nothing launched\n", n_in, n_in > 0 ? in_sizes[0] : -1, out_size, ws_size); grid = -1; return; }
        int dev = 0, cus = 0, per_cu = 0;
        if (hipGetDevice(&dev) != hipSuccess || hipDeviceGetAttribute(&cus, hipDeviceAttributeMultiprocessorCount, dev) != hipSuccess) { fprintf(stderr, "kernel_launch: device query failed\n"); grid = -1; return; }
        if (hipFuncSetAttribute((const void*)hyb_fwd, hipFuncAttributeMaxDynamicSharedMemorySize, LDS_BYTES) != hipSuccess) { fprintf(stderr, "kernel_launch: hipFuncSetAttribute failed\n"); grid = -1; return; }
        if (hipOccupancyMaxActiveBlocksPerMultiprocessor(&per_cu, (const void*)hyb_fwd, NTHREADS, LDS_BYTES) != hipSuccess || per_cu < 1) { fprintf(stderr, "kernel_launch: occupancy query reports %d workgroups per CU\n", per_cu); per_cu = 1; }
        (void)hipGetLastError();
        grid = cus;
    }
    if (grid < 0) return;
    if (hipMemsetAsync((char*)d_ws + WS_CTL, 0, CTL_ZERO_BYTES, stream) != hipSuccess) { fprintf(stderr, "kernel_launch: hipMemsetAsync failed\n"); return; }
    Args a{};
    a.x = (const float*)d_in[0]; a.pos = (const int*)d_in[1]; a.ln_g = (const float*)d_in[2]; a.w_in = (const float*)d_in[3]; a.qn_g = (const float*)d_in[4]; a.w_q_b = (const float*)d_in[5];
    a.kvn_g = (const float*)d_in[6]; a.w_kv_b = (const float*)d_in[7]; a.hg_lb = (const float*)d_in[8]; a.hg_ng = (const float*)d_in[9]; a.w_out = (const float*)d_in[10]; a.fn_g = (const float*)d_in[11];
    a.out = (float*)d_out; a.ws = (unsigned char*)d_ws;
#if MK_PER_PHASE
    for (int p = 0; p < N_PHASES; ++p) { a.ph_lo = p; a.ph_hi = p + 1; hipLaunchKernelGGL(hyb_fwd, dim3(grid), dim3(NTHREADS), LDS_BYTES, stream, a); }
#else
    a.ph_lo = 0; a.ph_hi = N_PHASES; hipLaunchKernelGGL(hyb_fwd, dim3(grid), dim3(NTHREADS), LDS_BYTES, stream, a);
#endif
    const hipError_t le = hipPeekAtLastError();
    if (le != hipSuccess) fprintf(stderr, "kernel_launch: launch failed: %s\n", hipGetErrorName(le));
}
```

```cpp
#include <hip/hip_runtime.h>
#include <hip/hip_bf16.h>
#include <cstdio>
#include <cstdint>

constexpr int BATCH = 8, SEQ = 4096, DMODEL = 1024, MTOK = BATCH * SEQ;
constexpr int D_IN = 2976, N1 = 3072;
constexpr int NHEAD = 8, NOPE = 64, ROPE = 32, VDIM = 64, QRANK = 256, KVRANK = 128, QHD = NOPE + ROPE;
constexpr int NQ = NHEAD * QHD  , NKV = NHEAD * (NOPE + VDIM)  , MLAW = NHEAD * VDIM  ;
constexpr int HGH = 4, HGD = 128, HGW = 512, CHUNK = 64, NCHUNK = SEQ / CHUNK;
constexpr float EPS = 1e-6f;
constexpr float QSCALE = 0.1472444460259031f;
constexpr int C_QLAT = 0, C_KVLAT = 256, C_KROPE = 384, C_GMLA = 416, C_HQ = 928, C_HF = 1440, C_HI = 1952, C_GHG = 2464;

constexpr size_t MiB = 1u << 20;
constexpr size_t WS_CTL = 0, CTL_ZERO_BYTES = 64 * 1024;
constexpr size_t WS_W1T = 2 * MiB;
constexpr size_t WS_WQT = 8 * MiB;
constexpr size_t WS_WKVT = 8 * MiB + 512 * 1024;
constexpr size_t WS_WOT = 9 * MiB;
constexpr size_t WS_CS = 11 * MiB;
constexpr size_t WS_LB = 15 * MiB;
constexpr size_t WS_SSQQ = 16 * MiB, WS_SSQKV = 16 * MiB + 512 * 1024;
constexpr size_t WS_SSQO = 17 * MiB;
constexpr size_t WS_ER = 19 * MiB, WS_EER = 20 * MiB;
constexpr size_t WS_XN = 32 * MiB;
constexpr size_t WS_Y = 32 * MiB;
constexpr size_t WS_QLAT = 96 * MiB, WS_KVLAT = 112 * MiB, WS_KPE = 120 * MiB;
constexpr size_t WS_GMLA = 128 * MiB, WS_QG = 160 * MiB, WS_KG = 192 * MiB, WS_HV = 224 * MiB, WS_GHG = 256 * MiB;
constexpr size_t WS_Q = 288 * MiB;
constexpr size_t WS_KN = 336 * MiB, WS_V = 368 * MiB;
constexpr size_t WS_OS = 400 * MiB;
constexpr size_t WS_END = 464 * MiB;
constexpr int CW_BAR = 1024;
constexpr int CW_QUEUE = 8192;
static_assert((CW_BAR + 3456) * 4 <= (int)CTL_ZERO_BYTES && (CW_QUEUE + 64 * 16) * 4 <= (int)CTL_ZERO_BYTES, "CTL words inside the memset region");

namespace pg8 {
#define PG8_LAS __attribute__((address_space(3)))
typedef unsigned short bf16_t;
typedef short bf16x8 __attribute__((ext_vector_type(8)));
typedef float f32x4 __attribute__((ext_vector_type(4)));
typedef unsigned u32x4 __attribute__((ext_vector_type(4)));
constexpr int BM = 256, BK = 64, HALF = 128, HTB = HALF * BK * 2  , STAGE_BYTES = 8 * HTB, NXCD = 8, WGM = 8;

__host__ __device__ __forceinline__ int lds_byte(int r, int c) { const int st = (r >> 4) * 2 + (c >> 5), rr = r & 15, cc = c & 31, ob = rr * 64 + cc * 2; return st * 1024 + (ob ^ (((ob >> 9) & 1) << 5)); }
__host__ __device__ __forceinline__ void stage_rc(int b, int& R, int& C) { const int st = b / 1024, sb = b % 1024, swz = sb ^ (((sb >> 9) & 1) << 5); R = (st >> 1) * 16 + swz / 64; C = (st & 1) * 32 + (swz % 64) / 2; }
__host__ __device__ __forceinline__ int perm32(int rho) { const int n = rho >> 4, i = rho & 15; return 8 * (i >> 2) + 4 * n + (i & 3); }

struct Unit { int pm, pn; };
struct Gemm { const bf16_t* A; const bf16_t* Bt; int M, N, K; };

struct StaticOrder {
    int nM, nN, nwg, G, c;
    __host__ __device__ void init(int M, int N, int G_, int c_) { nM = M / BM; nN = N / BM; nwg = nM * nN; G = G_; c = c_; }
    __host__ __device__ bool next(int i, Unit& u) const {
        const long L = (long)i * G + c; if (L >= nwg) return false;
        int wgid = (int)L; { const int q = nwg / NXCD, r = nwg % NXCD, xcd = wgid % NXCD, off = wgid / NXCD; wgid = (xcd < r ? xcd * (q + 1) : r * (q + 1) + (xcd - r) * q) + off; }
        const int nig = WGM * nN, gid = wgid / nig, fm = gid * WGM, gsz = (nM - fm) < WGM ? (nM - fm) : WGM;
        u.pm = fm + ((wgid % nig) % gsz); u.pn = (wgid % nig) / gsz; return true;
    }
    __device__ __forceinline__ void a_ready(const Unit&) const {}
    __device__ __forceinline__ void done(const Unit&) const {}
};

__device__ __forceinline__ unsigned cvt_pk_bf16(float lo, float hi) { unsigned r; asm volatile("v_cvt_pk_bf16_f32 %0, %1, %2" : "=v"(r) : "v"(lo), "v"(hi)); return r; }
typedef float f32x2e __attribute__((ext_vector_type(2)));
__device__ __forceinline__ void st8(bf16_t* p, const f32x4& a, const f32x4& b) {
    u32x4 w; w.x = cvt_pk_bf16(a[0], a[1]); w.y = cvt_pk_bf16(a[2], a[3]); w.z = cvt_pk_bf16(b[0], b[1]); w.w = cvt_pk_bf16(b[2], b[3]);
    *(u32x4*)p = w;
}
__device__ __forceinline__ float sigm(float x) { return __builtin_amdgcn_rcpf(1.0f + __expf(-x)); }
__device__ __forceinline__ float silu_f(float x) { return x * sigm(x); }
__device__ __forceinline__ f32x4 silu4(const f32x4& v) { f32x4 o; o[0] = silu_f(v[0]); o[1] = silu_f(v[1]); o[2] = silu_f(v[2]); o[3] = silu_f(v[3]); return o; }
__device__ __forceinline__ float sq4(const f32x4& v) { return (v[0] * v[0] + v[1] * v[1]) + (v[2] * v[2] + v[3] * v[3]); }
template <int SH> __device__ __forceinline__ float dpp_shr(float v) {
    return __builtin_bit_cast(float, __builtin_amdgcn_update_dpp(0, __builtin_bit_cast(int, v), 0x110 + SH, 0xf, 0xf, true));
}
__device__ __forceinline__ float scan16(float v) { v += dpp_shr<1>(v); v += dpp_shr<2>(v); v += dpp_shr<4>(v); v += dpp_shr<8>(v); return v; }
__device__ __forceinline__ float clampe(float x) { return fminf(fmaxf(x, -80.f), 80.f); }

struct EpiP1 {
    static constexpr bool PERM = true, AFTER_DRAIN = false;
    unsigned char* ws;
    __device__ __forceinline__ void operator()(const f32x4 (&acc)[2][2][4][2], const Unit& u, int wr, int wc, int fr, int fq) const {
        { int t_ = threadIdx.x; asm volatile("" : "+v"(t_)); fr = t_ & 15; fq = (t_ >> 4) & 3; }
        const int pn = u.pn, lane = fq * 16 + fr;
        bf16_t* const QLAT = (bf16_t*)(ws + WS_QLAT); bf16_t* const KVLAT = (bf16_t*)(ws + WS_KVLAT); bf16_t* const KPE = (bf16_t*)(ws + WS_KPE);
        bf16_t* const QG = (bf16_t*)(ws + WS_QG); bf16_t* const KG = (bf16_t*)(ws + WS_KG);
        float* const SSQQ = (float*)(ws + WS_SSQQ); float* const SSQKV = (float*)(ws + WS_SSQKV); float* const ER = (float*)(ws + WS_ER); float* const EER = (float*)(ws + WS_EER);
        const float* const LB = (const float*)(ws + WS_LB); const f32x2e* const CS = (const f32x2e*)(ws + WS_CS);
        const int rowb = u.pm * BM + wr * 64 + fr, cw = wc * 32 + 8 * fq;
        if (pn == 0) {
#pragma unroll
            for (int ai = 0; ai < 2; ++ai)
#pragma unroll
                for (int m = 0; m < 4; ++m) { const size_t row = (size_t)(rowb + ai * HALF + m * 16); float s = 0.f;
#pragma unroll
                    for (int bj = 0; bj < 2; ++bj) { const f32x4 v0 = acc[ai][bj][m][0], v1 = acc[ai][bj][m][1]; s += sq4(v0) + sq4(v1); st8(QLAT + row * QRANK + bj * HALF + cw, v0, v1); }
                    s += __shfl_xor(s, 16); s += __shfl_xor(s, 32); if (fq == 0) SSQQ[row * 4 + wc] = s; }
        } else if (pn == 1) {
#pragma unroll
            for (int ai = 0; ai < 2; ++ai)
#pragma unroll
                for (int m = 0; m < 4; ++m) { const size_t row = (size_t)(rowb + ai * HALF + m * 16);
                    const f32x4 v0 = acc[ai][0][m][0], v1 = acc[ai][0][m][1]; float s = sq4(v0) + sq4(v1); st8(KVLAT + row * KVRANK + cw, v0, v1);
                    s += __shfl_xor(s, 16); s += __shfl_xor(s, 32); if (fq == 0) SSQKV[row * 4 + wc] = s;
                    if (wc == 0) {
                        const f32x4 x0 = acc[ai][1][m][0], x1 = acc[ai][1][m][1]; f32x4 p0, p1, o0, o1;
#pragma unroll
                        for (int j = 0; j < 4; ++j) { p0[j] = __shfl_xor(x0[j], 32); p1[j] = __shfl_xor(x1[j], 32); }
                        const f32x2e* cs = CS + row * 16 + 8 * (fq & 1); const float sg = (fq < 2) ? -1.f : 1.f;
#pragma unroll
                        for (int j = 0; j < 4; ++j) { const f32x2e c0 = cs[j], c1 = cs[4 + j]; o0[j] = x0[j] * c0.x + sg * p0[j] * c0.y; o1[j] = x1[j] * c1.x + sg * p1[j] * c1.y; }
                        st8(KPE + row * ROPE + 8 * fq, o0, o1);
                    } }
        } else if (pn < 4 || pn >= 8) {
            size_t doff; bool act; int colt;
            if (pn < 4) { doff = WS_GMLA; act = true; colt = (pn - 2) * BM; } else if (pn < 10) { doff = WS_HV; act = false; colt = (pn - 8) * BM; } else { doff = WS_GHG; act = true; colt = (pn - 10) * BM; }
            bf16_t* const dst = (bf16_t*)(ws + doff);
#pragma unroll
            for (int ai = 0; ai < 2; ++ai)
#pragma unroll
                for (int m = 0; m < 4; ++m) { const size_t row = (size_t)(rowb + ai * HALF + m * 16);
#pragma unroll
                    for (int bj = 0; bj < 2; ++bj) { f32x4 v0 = acc[ai][bj][m][0], v1 = acc[ai][bj][m][1]; if (act) { v0 = silu4(v0); v1 = silu4(v1); }
                        st8(dst + row * 512 + colt + bj * HALF + cw, v0, v1); } }
        } else {
            const int ch0 = (pn - 4) * HGD + cw;
#pragma unroll
            for (int ai = 0; ai < 2; ++ai) {
                const int gch = (u.pm * BM + ai * HALF + wr * 64) >> 6;
                f32x4 qo[4][2], ko[4][2];
#pragma unroll
                for (int n = 0; n < 2; ++n)
#pragma unroll
                    for (int j = 0; j < 4; ++j) { const float lb = LB[ch0 + 4 * n + j], oml = 1.f - lb;
                        float g[4], kk[4];
#pragma unroll
                        for (int m = 0; m < 4; ++m) { const float x = acc[ai][1][m][n][j]; const float f = lb + oml * sigm(x); kk[m] = oml * sigm(-x); g[m] = scan16(__logf(f)); }
                        const int l15 = (lane & 48) | 15;
                        const float t0 = __shfl(g[0], l15), t1 = __shfl(g[1], l15), t2 = __shfl(g[2], l15), t3 = __shfl(g[3], l15);
                        g[1] += t0; g[2] += t0 + t1; g[3] += (t0 + t1) + t2;
                        const float R = t0 + t1, Gend = (t0 + t1) + (t2 + t3);
#pragma unroll
                        for (int m = 0; m < 4; ++m) { const float d = clampe(g[m] - R); qo[m][n][j] = silu_f(acc[ai][0][m][n][j]) * __expf(d); ko[m][n][j] = kk[m] * __expf(-d); }
                        if (fr == 15) { ER[(size_t)gch * HGW + ch0 + 4 * n + j] = __expf(clampe(R)); EER[(size_t)gch * HGW + ch0 + 4 * n + j] = __expf(clampe(Gend - R)); }
                    }
#pragma unroll
                for (int m = 0; m < 4; ++m) { const size_t row = (size_t)(rowb + ai * HALF + m * 16); st8(QG + row * HGW + ch0, qo[m][0], qo[m][1]); st8(KG + row * HGW + ch0, ko[m][0], ko[m][1]); }
            }
        }
    }
};

struct EpiQ {
    static constexpr bool PERM = true, AFTER_DRAIN = false;
    bf16_t* Q; const float* SSQQ; const f32x2e* CS;
    __device__ __forceinline__ void operator()(const f32x4 (&acc)[2][2][4][2], const Unit& u, int wr, int wc, int fr, int fq) const {
        { int t_ = threadIdx.x; asm volatile("" : "+v"(t_)); fr = t_ & 15; fq = (t_ >> 4) & 3; }
        const int rowb = u.pm * BM + wr * 64 + fr;
#pragma unroll
        for (int ai = 0; ai < 2; ++ai)
#pragma unroll
            for (int m = 0; m < 4; ++m) { const size_t row = (size_t)(rowb + ai * HALF + m * 16);
                const f32x4 sq = *(const f32x4*)(SSQQ + row * 4); const float rs = rsqrtf(((sq[0] + sq[1]) + (sq[2] + sq[3])) * (1.f / QRANK) + EPS) * QSCALE;
#pragma unroll
                for (int bj = 0; bj < 2; ++bj) { const int g32 = u.pn * 8 + bj * 4 + wc;
                    f32x4 x0 = acc[ai][bj][m][0] * rs, x1 = acc[ai][bj][m][1] * rs;
                    if (g32 % 3 == 2) {
                        f32x4 p0, p1, o0, o1;
#pragma unroll
                        for (int j = 0; j < 4; ++j) { p0[j] = __shfl_xor(x0[j], 32); p1[j] = __shfl_xor(x1[j], 32); }
                        const f32x2e* cs = CS + row * 16 + 8 * (fq & 1); const float sg = (fq < 2) ? -1.f : 1.f;
#pragma unroll
                        for (int j = 0; j < 4; ++j) { const f32x2e c0 = cs[j], c1 = cs[4 + j]; o0[j] = x0[j] * c0.x + sg * p0[j] * c0.y; o1[j] = x1[j] * c1.x + sg * p1[j] * c1.y; }
                        x0 = o0; x1 = o1;
                    }
                    st8(Q + row * NQ + g32 * 32 + 8 * fq, x0, x1); } }
    }
};
struct EpiKV {
    static constexpr bool PERM = true, AFTER_DRAIN = false;
    bf16_t *KN, *V; const float* SSQKV;
    __device__ __forceinline__ void operator()(const f32x4 (&acc)[2][2][4][2], const Unit& u, int wr, int wc, int fr, int fq) const {
        { int t_ = threadIdx.x; asm volatile("" : "+v"(t_)); fr = t_ & 15; fq = (t_ >> 4) & 3; }
        const int rowb = u.pm * BM + wr * 64 + fr;
#pragma unroll
        for (int ai = 0; ai < 2; ++ai)
#pragma unroll
            for (int m = 0; m < 4; ++m) { const size_t row = (size_t)(rowb + ai * HALF + m * 16);
                const f32x4 sq = *(const f32x4*)(SSQKV + row * 4); const float rs = rsqrtf(((sq[0] + sq[1]) + (sq[2] + sq[3])) * (1.f / KVRANK) + EPS);
#pragma unroll
                for (int bj = 0; bj < 2; ++bj) { const int g32 = u.pn * 8 + bj * 4 + wc, h = g32 >> 2, part = g32 & 3;
                    bf16_t* dst = (part < 2 ? KN : V) + row * 512 + h * 64 + (part & 1) * 32 + 8 * fq;
                    st8(dst, acc[ai][bj][m][0] * rs, acc[ai][bj][m][1] * rs); } }
    }
};
struct EpiOut {
    static constexpr bool PERM = false, AFTER_DRAIN = false;
    const float* X; float* OUT; float* SSQO;
    __device__ __forceinline__ void operator()(const f32x4 (&acc)[2][2][4][2], const Unit& u, int wr, int wc, int fr, int fq) const {
        { int t_ = threadIdx.x; asm volatile("" : "+v"(t_)); fr = t_ & 15; fq = (t_ >> 4) & 3; }
        const int rowb = u.pm * BM + wr * 64 + fr, col0 = u.pn * BM + wc * 32 + 4 * fq;
#pragma unroll
        for (int ai = 0; ai < 2; ++ai)
#pragma unroll
            for (int m = 0; m < 4; ++m) { const size_t off = (size_t)(rowb + ai * HALF + m * 16) * DMODEL + col0; float s = 0.f;
#pragma unroll
                for (int bj = 0; bj < 2; ++bj)
#pragma unroll
                    for (int n = 0; n < 2; ++n) { const f32x4 v = acc[ai][bj][m][n] + *(const f32x4*)(X + off + bj * HALF + n * 16); s += sq4(v); *(f32x4*)(OUT + off + bj * HALF + n * 16) = v; }
                s += __shfl_xor(s, 16); s += __shfl_xor(s, 32); if (fq == 0) SSQO[(size_t)(rowb + ai * HALF + m * 16) * 16 + u.pn * 4 + wc] = s; }
    }
};
template <class Epi, class Sched, bool ALIGN_EPI = false, bool SP2 = false>
__device__ __forceinline__ void gemm_phase(PG8_LAS unsigned char* lds, const Gemm g, const Sched& S, const Epi& E) {
    int tid_ = threadIdx.x; asm volatile("" : "+v"(tid_));
    const int tid = tid_, wid = __builtin_amdgcn_readfirstlane(tid >> 6), lane = tid & 63, wr = wid >> 2, wc = wid & 3, fr = lane & 15, fq = lane >> 4;
    const int K = g.K, nt = K / BK;
    unsigned voffA[2], voffB[2];
#pragma unroll
    for (int i = 0; i < 2; ++i) { int R, C; stage_rc(tid * 16 + i * 8192, R, C); const int Rb = Epi::PERM ? ((R & ~31) + perm32(R & 31)) : R;
        voffA[i] = (unsigned)(R * K + C) * 2u; voffB[i] = (unsigned)(Rb * K + C) * 2u; }
    const size_t kstep = (size_t)(BK * 2);
    const size_t hstep = (size_t)HALF * K * 2;
    const size_t tstep = 2 * hstep;
    const unsigned ldsw = (unsigned)wid * 1024u;
    const int aoff = lds_byte(wr * 64 + fr, fq * 8), boff = lds_byte(wc * 32 + fr, fq * 8);
#define PG8_SA(b, h) (((b) * 2 + (h)) * HTB)
#define PG8_SB(b, h) ((4 + (b) * 2 + (h)) * HTB)
#define PG8_STAGE(bufoff, gbase, voff) do { _Pragma("unroll") for (int _i = 0; _i < 2; ++_i) \
        __builtin_amdgcn_global_load_lds((const unsigned*)((const char*)(gbase) + (voff)[_i]), (PG8_LAS unsigned*)(lds + (bufoff) + ldsw + _i * 8192), 16, 0, 0); } while (0)
#define PG8_LDA(dst, b, h) do { _Pragma("unroll") for (int m = 0; m < 4; ++m) _Pragma("unroll") for (int k = 0; k < 2; ++k) dst[m][k] = *(const PG8_LAS bf16x8*)(lds + PG8_SA(b, h) + aoff + m * 2048 + k * 1024); } while (0)
#define PG8_LDB(dst, b, h) do { _Pragma("unroll") for (int n = 0; n < 2; ++n) _Pragma("unroll") for (int k = 0; k < 2; ++k) dst[n][k] = *(const PG8_LAS bf16x8*)(lds + PG8_SB(b, h) + boff + n * 2048 + k * 1024); } while (0)
#define PG8_MMA(ai, bj, At, Bt) do { __builtin_amdgcn_s_setprio(1); _Pragma("unroll") for (int m = 0; m < 4; ++m) _Pragma("unroll") for (int n = 0; n < 2; ++n) _Pragma("unroll") for (int k = 0; k < 2; ++k) \
        acc[ai][bj][m][n] = __builtin_amdgcn_mfma_f32_16x16x32_bf16(Bt[n][k], At[m][k], acc[ai][bj][m][n], 0, 0, 0); __builtin_amdgcn_s_setprio(0); } while (0)
#define PG8_WAIT_V(n) asm volatile("s_waitcnt vmcnt(" #n ")" ::: "memory")
#define PG8_WAIT_L(n) asm volatile("s_waitcnt lgkmcnt(" #n ")" ::: "memory")
#define PG8_BAR __builtin_amdgcn_s_barrier()
#define PG8_SCHED __builtin_amdgcn_sched_barrier(0)
    Unit cur, nxt; int ui = 0;
    if (!S.next(0, cur)) return;
    f32x4 acc[2][2][4][2];
#pragma unroll
    for (int a = 0; a < 2; ++a)
#pragma unroll
        for (int b = 0; b < 2; ++b)
#pragma unroll
            for (int m = 0; m < 4; ++m)
#pragma unroll
                for (int n = 0; n < 2; ++n) acc[a][b][m][n] = (f32x4){0.f, 0.f, 0.f, 0.f};
    bf16x8 At[4][2], B0[2][2], B1[2][2];
    const char* cA = (const char*)g.A + (size_t)cur.pm * tstep; const char* cB = (const char*)g.Bt + (size_t)cur.pn * tstep;
    S.a_ready(cur);
    if constexpr (SP2) {
        PG8_STAGE(PG8_SB(0, 0), cB, voffB); PG8_STAGE(PG8_SB(0, 1), cB + hstep, voffB); PG8_STAGE(PG8_SA(0, 0), cA, voffA); PG8_STAGE(PG8_SA(0, 1), cA + hstep, voffA);
        if (wr == 1) PG8_BAR;
        PG8_WAIT_V(2); PG8_BAR;
        PG8_STAGE(PG8_SB(1, 0), cB + kstep, voffB); PG8_STAGE(PG8_SA(1, 0), cA + kstep, voffA); PG8_STAGE(PG8_SB(1, 1), cB + hstep + kstep, voffB);
        PG8_WAIT_V(6); PG8_BAR;
    } else {
        PG8_STAGE(PG8_SB(0, 0), cB, voffB); PG8_STAGE(PG8_SA(0, 0), cA, voffA); PG8_STAGE(PG8_SB(0, 1), cB + hstep, voffB); PG8_STAGE(PG8_SA(0, 1), cA + hstep, voffA);
        if (wr == 1) PG8_BAR;
        PG8_WAIT_V(4); PG8_BAR;
        PG8_STAGE(PG8_SB(1, 0), cB + kstep, voffB); PG8_STAGE(PG8_SA(1, 0), cA + kstep, voffA); PG8_STAGE(PG8_SB(1, 1), cB + hstep + kstep, voffB);
        PG8_WAIT_V(6); PG8_BAR;
    }
    for (;;) {
        const bool has_next = S.next(ui + 1, nxt);
        const char* nA = has_next ? (const char*)g.A + (size_t)nxt.pm * tstep : cA; const char* nB = has_next ? (const char*)g.Bt + (size_t)nxt.pn * tstep : cB;
        for (int t = 0; t < nt; t += 2) {
            const bool last = (t == nt - 2);
            const char* a1 = cA + (size_t)(t + 1) * kstep;
            const char* a2 = last ? nA : cA + (size_t)(t + 2) * kstep; const char* b2 = last ? nB : cB + (size_t)(t + 2) * kstep;
            const char* a3 = a2 + kstep; const char* b3 = b2 + kstep;
            if (last && has_next) S.a_ready(nxt);
            if constexpr (SP2) {
            PG8_LDB(B0, 0, 0); PG8_LDB(B1, 0, 1); PG8_SCHED; PG8_LDA(At, 0, 0); PG8_STAGE(PG8_SA(1, 1), a1 + hstep, voffA);
            PG8_WAIT_V(8); PG8_WAIT_L(0); PG8_BAR; PG8_MMA(0, 0, At, B0); PG8_MMA(0, 1, At, B1); PG8_BAR; PG8_SCHED;
            PG8_LDA(At, 0, 1); PG8_STAGE(PG8_SB(0, 0), b2, voffB); PG8_STAGE(PG8_SB(0, 1), b2 + hstep, voffB); PG8_STAGE(PG8_SA(0, 0), a2, voffA);
            PG8_WAIT_V(8); PG8_WAIT_L(0); PG8_BAR; PG8_MMA(1, 0, At, B0); PG8_MMA(1, 1, At, B1); PG8_BAR; PG8_SCHED;
            PG8_LDB(B0, 1, 0); PG8_LDB(B1, 1, 1); PG8_SCHED; PG8_LDA(At, 1, 0); PG8_STAGE(PG8_SA(0, 1), a2 + hstep, voffA);
            PG8_WAIT_V(8); PG8_WAIT_L(0); PG8_BAR; PG8_MMA(0, 0, At, B0); PG8_MMA(0, 1, At, B1); PG8_BAR; PG8_SCHED;
            PG8_LDA(At, 1, 1); PG8_STAGE(PG8_SB(1, 0), b3, voffB); PG8_STAGE(PG8_SB(1, 1), b3 + hstep, voffB); PG8_STAGE(PG8_SA(1, 0), a3, voffA);
            PG8_WAIT_V(8); PG8_WAIT_L(0); PG8_BAR; PG8_MMA(1, 0, At, B0); PG8_MMA(1, 1, At, B1); PG8_BAR; PG8_SCHED;
            } else {
            PG8_LDB(B0, 0, 0); PG8_SCHED; PG8_LDA(At, 0, 0); PG8_STAGE(PG8_SA(1, 1), a1 + hstep, voffA);
            PG8_WAIT_L(8); PG8_BAR; PG8_WAIT_L(0); PG8_MMA(0, 0, At, B0); PG8_BAR; PG8_SCHED;
            PG8_LDB(B1, 0, 1); PG8_STAGE(PG8_SB(0, 0), b2, voffB);
            PG8_BAR; PG8_WAIT_L(0); PG8_MMA(0, 1, At, B1); PG8_BAR;
            PG8_LDA(At, 0, 1); PG8_STAGE(PG8_SA(0, 0), a2, voffA);
            PG8_BAR; PG8_WAIT_L(0); PG8_MMA(1, 0, At, B0); PG8_BAR; PG8_SCHED;
            PG8_STAGE(PG8_SB(0, 1), b2 + hstep, voffB);
            PG8_WAIT_V(6); PG8_BAR; PG8_MMA(1, 1, At, B1); PG8_BAR;
            PG8_LDB(B0, 1, 0); PG8_SCHED; PG8_LDA(At, 1, 0); PG8_STAGE(PG8_SA(0, 1), a2 + hstep, voffA);
            PG8_WAIT_L(8); PG8_BAR; PG8_WAIT_L(0); PG8_MMA(0, 0, At, B0); PG8_BAR; PG8_SCHED;
            PG8_LDB(B1, 1, 1); PG8_STAGE(PG8_SB(1, 0), b3, voffB);
            PG8_BAR; PG8_WAIT_L(0); PG8_MMA(0, 1, At, B1); PG8_BAR;
            PG8_LDA(At, 1, 1); PG8_STAGE(PG8_SA(1, 0), a3, voffA);
            PG8_BAR; PG8_WAIT_L(0); PG8_MMA(1, 0, At, B0); PG8_BAR; PG8_SCHED;
            PG8_STAGE(PG8_SB(1, 1), b3 + hstep, voffB);
            PG8_WAIT_V(6); PG8_BAR; PG8_MMA(1, 1, At, B1); PG8_BAR;
            }
        }
        if constexpr (ALIGN_EPI) { if (wr == 0) PG8_BAR; }
        if constexpr (!Epi::AFTER_DRAIN) { E(acc, cur, wr, wc, fr, fq); S.done(cur); }
        if (!has_next) break;
#pragma unroll
        for (int a = 0; a < 2; ++a)
#pragma unroll
            for (int b = 0; b < 2; ++b)
#pragma unroll
                for (int m = 0; m < 4; ++m)
#pragma unroll
                    for (int n = 0; n < 2; ++n) acc[a][b][m][n] = (f32x4){0.f, 0.f, 0.f, 0.f};
        cur = nxt; cA = nA; cB = nB; ++ui;
        if constexpr (ALIGN_EPI) { if (wr == 1) PG8_BAR; }
    }
    PG8_WAIT_V(0);
    if constexpr (!ALIGN_EPI) { if (wr == 0) PG8_BAR; }
    PG8_BAR;
    if constexpr (Epi::AFTER_DRAIN) { E.fused(acc, cur, wr, wc, fr, fq, lds, wid, lane); S.done(cur); }
#undef PG8_SA
#undef PG8_SB
#undef PG8_STAGE
#undef PG8_LDA
#undef PG8_LDB
#undef PG8_MMA
#undef PG8_WAIT_V
#undef PG8_WAIT_L
#undef PG8_BAR
#undef PG8_SCHED
}
}

#ifndef PG8_SP2
#define PG8_SP2 true
#endif
#define GAS __attribute__((address_space(1)))
#define LAS __attribute__((address_space(3)))
typedef unsigned short bf16;
typedef unsigned v4u __attribute__((ext_vector_type(4)));
typedef float f32x4 __attribute__((ext_vector_type(4)));
typedef short bf16x8 __attribute__((ext_vector_type(8)));
typedef GAS unsigned gu32;
typedef GAS unsigned long long gu64;
#define RLX_AGENT __ATOMIC_RELAXED, __HIP_MEMORY_SCOPE_AGENT
#define LDS_WAIT() asm volatile("s_waitcnt lgkmcnt(0)" ::: "memory")
#define VM_WAIT() asm volatile("s_waitcnt vmcnt(0)" ::: "memory")
__device__ __forceinline__ unsigned long long rt() { return __builtin_amdgcn_s_memrealtime(); }
__device__ __forceinline__ unsigned f2bf(float f) { unsigned u = __builtin_bit_cast(unsigned, f); return (u + 0x7fffu + ((u >> 16) & 1u)) >> 16; }
__device__ __forceinline__ unsigned pk2(float lo, float hi) { return f2bf(lo) | (f2bf(hi) << 16); }
#define XB_TMO      128
#define XB_XCNT(j)  (256  + 64 * (j))
#define XB_XSUB(j)  (1280 + 64 * (j))
#define XB_XGEN(j)  (2304 + 64 * (j))
#define XB_TOP      3328
#define XB_TOPGEN   3392
#define XCD_BAR_WORDS 3456
#define XB_SPIN_CAP (1u << 18)

__device__ __forceinline__ unsigned xb_ld(unsigned* p)              { return __hip_atomic_load(p, __ATOMIC_RELAXED, __HIP_MEMORY_SCOPE_AGENT); }
__device__ __forceinline__ unsigned xb_add(unsigned* p, unsigned v) { return __hip_atomic_fetch_add(p, v, __ATOMIC_RELAXED, __HIP_MEMORY_SCOPE_AGENT); }
__device__ __forceinline__ unsigned xb_xcc_id() { return (unsigned)__builtin_amdgcn_s_getreg((3 << 11) | 20) & 0xFu; }
#define XB_SPIN(cond, bar) do { unsigned _sp = 0; while (cond) { __builtin_amdgcn_s_sleep(1); \
    if ((++_sp & 255u) == 0u) { if (xb_ld(&(bar)[XB_TMO])) break; if (_sp > XB_SPIN_CAP) { atomicAdd(&(bar)[XB_TMO], 1u); break; } } } } while (0)

struct XcdBarrier {
    unsigned* bar; unsigned x;
    volatile LAS unsigned* st;
};

__device__ __forceinline__ XcdBarrier xcd_barrier_post(unsigned* bar, volatile LAS unsigned* st) {
    XcdBarrier b; b.bar = bar; b.x = xb_xcc_id(); b.st = st;
    if (threadIdx.x == 0) (void)xb_add(&bar[XB_XCNT(b.x)], 1u);
    return b;
}
__device__ __forceinline__ void xcd_barrier_complete(unsigned* bar, unsigned x, unsigned& nloc, unsigned& nx) {
    const unsigned G = gridDim.x * gridDim.y * gridDim.z;
    unsigned sum, cnt, mine, sp = 0u;
    for (;;) {
        sum = 0u; cnt = 0u; mine = 0u;
#pragma unroll
        for (unsigned j = 0; j < 16; ++j) { const unsigned c = xb_ld(&bar[XB_XCNT(j)]); sum += c; cnt += (c > 0u) ? 1u : 0u; mine = (j == x) ? c : mine; }
        if (sum == G) break;
        __builtin_amdgcn_s_sleep(1);
        if ((++sp & 255u) == 0u) { if (xb_ld(&bar[XB_TMO])) break; if (sp > XB_SPIN_CAP) { atomicAdd(&bar[XB_TMO], 1u); break; } }
    }
    nloc = mine > 0u ? mine : 1u; nx = cnt > 0u ? cnt : 1u;
}

__device__ __forceinline__ void xcd_barrier(const XcdBarrier& b) {
    asm volatile("s_waitcnt vmcnt(0)" ::: "memory");
    __syncthreads();
    if (threadIdx.x == 0) {
        unsigned* bar = b.bar;
        __builtin_amdgcn_s_waitcnt(0);
        unsigned nloc = b.st[0], nx = b.st[1];
        if (nloc == 0u) { xcd_barrier_complete(bar, b.x, nloc, nx); b.st[0] = nloc; b.st[1] = nx; }
        const unsigned old = xb_add(&bar[XB_XSUB(b.x)], 1u);
        const unsigned gen = old / nloc;
        if (old + 1u == (gen + 1u) * nloc) {
            __builtin_amdgcn_fence(__ATOMIC_RELEASE, "agent");
            asm volatile("s_waitcnt vmcnt(0)" ::: "memory");
            const unsigned og = xb_add(&bar[XB_TOP], 1u);
            const unsigned tg = og / nx;
            if (og + 1u == (tg + 1u) * nx) xb_add(&bar[XB_TOPGEN], 1u);
            else XB_SPIN(xb_ld(&bar[XB_TOPGEN]) == tg, bar);
            __builtin_amdgcn_fence(__ATOMIC_ACQUIRE, "agent");
            xb_add(&bar[XB_XGEN(b.x)], 1u);
            asm volatile("s_waitcnt vmcnt(0)" ::: "memory");
        } else {
            XB_SPIN(xb_ld(&bar[XB_XGEN(b.x)]) == gen, bar);
            __builtin_amdgcn_fence(__ATOMIC_ACQUIRE, "agent");
            asm volatile("s_waitcnt vmcnt(0)" ::: "memory");
        }
    }
    __syncthreads();
}

constexpr int NWAVES = 8, NTHREADS = 512;
constexpr int RING_BYTES = 131072, LDSCTL_OFF = RING_BYTES, MISC_OFF = LDSCTL_OFF + 320, LDS_BYTES = 147456;

struct Args { const float* x; const int* pos; const float *ln_g, *w_in, *qn_g, *w_q_b, *kvn_g, *w_kv_b, *hg_lb, *hg_ng, *w_out, *fn_g; float* out; unsigned char* ws; int ph_lo, ph_hi; };

__device__ __forceinline__ float wave_sum(float v) {
#pragma unroll
    for (int o = 1; o < 64; o <<= 1) v += __shfl_xor(v, o);
    return v;
}
__device__ __forceinline__ int tid_opaque() { int t = threadIdx.x; asm volatile("" : "+v"(t)); return t; }
__device__ __forceinline__ float bf2f(bf16 b) { return __builtin_bit_cast(float, (unsigned)b << 16); }

__device__ const double INV_FREQ[16] = {1.0, 0.5623413251903491, 0.31622776601683794, 0.1778279410038923, 0.1, 0.05623413251903491, 0.03162277660168379, 0.01778279410038923,
                                        0.01, 0.005623413251903491, 0.0031622776601683794, 0.0017782794100389228, 0.001, 0.0005623413251903491, 0.00031622776601683794, 0.00017782794100389227};
__device__ __forceinline__ void p0_transpose_item(const float* W, int ldw, const float* kscale, bf16* WT, int ldt, int k0, int src_n0, int dst_n0, LAS float* scr, int lane) {
#pragma unroll 8
    for (int i = 0; i < 32; ++i) { const int kk = 2 * i + (lane >> 5); float v = 0.f;
        if (src_n0 >= 0) { v = W[(size_t)(k0 + kk) * ldw + src_n0 + (lane & 31)]; if (kscale) v *= kscale[k0 + kk]; }
        scr[kk * 33 + (lane & 31)] = v; }
    LDS_WAIT(); asm volatile("" ::: "memory");
    const int c = lane & 7;
#pragma unroll
    for (int j = 0; j < 4; ++j) { const int n = (lane >> 3) + 8 * j; const LAS float* s = scr + (8 * c) * 33 + n;
        v4u o; o.x = pk2(s[0 * 33], s[1 * 33]); o.y = pk2(s[2 * 33], s[3 * 33]); o.z = pk2(s[4 * 33], s[5 * 33]); o.w = pk2(s[6 * 33], s[7 * 33]);
        *(GAS v4u*)(WT + (size_t)(dst_n0 + n) * ldt + k0 + 8 * c) = o; }
    LDS_WAIT(); asm volatile("" ::: "memory");
}
__device__ __forceinline__ int w1_src_col(int n0) {
    if (n0 < 416) return n0;
    if (n0 < 512) return -1;
    if (n0 < 1024) return C_GMLA + (n0 - 512);
    if (n0 < 2048) { const int h = (n0 - 1024) >> 8, w = (n0 - 1024) & 255; return w < 128 ? C_HQ + 128 * h + w : C_HF + 128 * h + (w - 128); }
    if (n0 < 2560) return C_HI + (n0 - 2048);
    return C_GHG + (n0 - 2560);
}
__device__ __forceinline__ void p0_prologue(const Args& a, LAS unsigned char* lds, int vcu, int G) {
    const int tid = tid_opaque(), lane = tid & 63, wave = __builtin_amdgcn_readfirstlane(tid >> 6);
    unsigned char* ws = a.ws;
    LAS float* scr = (LAS float*)(lds + wave * 16384);
    const int gw = vcu * NWAVES + wave, NGW = G * NWAVES;
    constexpr int I_1 = (DMODEL / 64) * (N1 / 32), I_Q = (QRANK / 64) * (NQ / 32), I_KV = (KVRANK / 64) * (NKV / 32), I_O = (DMODEL / 64) * (DMODEL / 32);
    for (int it = gw; it < I_1 + I_Q + I_KV + I_O; it += NGW) {
        int r = it;
        if (r < I_1) { const int nb = r % (N1 / 32), kb = r / (N1 / 32); p0_transpose_item(a.w_in, D_IN, nullptr, (bf16*)(ws + WS_W1T), DMODEL, 64 * kb, w1_src_col(32 * nb), 32 * nb, scr, lane); continue; } r -= I_1;
        if (r < I_Q) { const int nb = r % (NQ / 32), kb = r / (NQ / 32); p0_transpose_item(a.w_q_b, NQ, a.qn_g, (bf16*)(ws + WS_WQT), QRANK, 64 * kb, 32 * nb, 32 * nb, scr, lane); continue; } r -= I_Q;
        if (r < I_KV) { const int nb = r % (NKV / 32), kb = r / (NKV / 32); p0_transpose_item(a.w_kv_b, NKV, a.kvn_g, (bf16*)(ws + WS_WKVT), KVRANK, 64 * kb, 32 * nb, 32 * nb, scr, lane); continue; } r -= I_KV;
        { const int nb = r % (DMODEL / 32), kb = r / (DMODEL / 32); p0_transpose_item(a.w_out, DMODEL, nullptr, (bf16*)(ws + WS_WOT), DMODEL, 64 * kb, 32 * nb, 32 * nb, scr, lane); }
    }
    f32x4 gv[4];
#pragma unroll
    for (int j = 0; j < 4; ++j) gv[j] = *((const f32x4*)a.ln_g + lane + 64 * j);
    for (int m = gw; m < MTOK; m += NGW) {
        const GAS f32x4* xr = (const GAS f32x4*)(a.x + (size_t)m * DMODEL) + lane;
        f32x4 v[4]; float s = 0.f;
#pragma unroll
        for (int j = 0; j < 4; ++j) { v[j] = xr[64 * j]; s += (v[j].x * v[j].x + v[j].y * v[j].y) + (v[j].z * v[j].z + v[j].w * v[j].w); }
        const float rstd = rsqrtf(wave_sum(s) * (1.f / DMODEL) + EPS);
        GAS unsigned long long* o8 = (GAS unsigned long long*)((bf16*)(ws + WS_XN) + (size_t)m * DMODEL) + lane;
#pragma unroll
        for (int j = 0; j < 4; ++j) { const f32x4 y = v[j] * rstd * gv[j]; o8[64 * j] = (unsigned long long)pk2(y.x, y.y) | ((unsigned long long)pk2(y.z, y.w) << 32); }
    }
    { const int gt = vcu * NTHREADS + wave * 64 + lane, NGT = G * NTHREADS;
      float2* cs = (float2*)(ws + WS_CS);
      for (int e = gt; e < MTOK * 16; e += NGT) { const int m = e >> 4, i = e & 15;
          double r = (double)a.pos[m] * INV_FREQ[i] * 0.15915494309189535; r -= floor(r);
          const float rf = (float)r; cs[e] = make_float2(__builtin_amdgcn_cosf(rf), __builtin_amdgcn_sinf(rf)); }
      if (gt < HGW) { const float a0 = a.hg_lb[gt], a1 = a.hg_lb[HGW + gt]; ((float*)(ws + WS_LB))[gt] = 1.f / (1.f + expf(a1 - a0)); }
    }
}

__device__ __forceinline__ void naive_attn_unit(int unit, const Args& a, LAS unsigned char* lds) {
    const int tid = tid_opaque();
    unsigned char* ws = a.ws;
    const bf16* Q = (const bf16*)(ws + WS_Q); const bf16* KN = (const bf16*)(ws + WS_KN); const bf16* KPE = (const bf16*)(ws + WS_KPE); const bf16* V = (const bf16*)(ws + WS_V);
    const bf16* GM = (const bf16*)(ws + WS_GMLA); bf16* Y = (bf16*)(ws + WS_Y);
    const int qb = unit & 7, h = (unit >> 3) & 7, b = unit >> 6;
    LAS float* Ks = (LAS float*)lds; LAS float* Vs = Ks + 64 * QHD;
    const int qrow = qb * 512 + tid; const size_t grow = (size_t)b * SEQ + qrow;
    float q[QHD], o[VDIM];
#pragma unroll
    for (int d = 0; d < QHD; ++d) q[d] = bf2f(Q[grow * NQ + h * QHD + d]);
#pragma unroll
    for (int d = 0; d < VDIM; ++d) o[d] = 0.f;
    float mx = -1e30f, l = 0.f;
    const int nt = (qb * 512 + 512) / 64;
    for (int j = 0; j < nt; ++j) {
        __syncthreads();
        for (int idx = tid; idx < 64 * QHD; idx += NTHREADS) { const int key = idx / QHD, d = idx % QHD; const size_t kr = (size_t)b * SEQ + 64 * j + key;
            Ks[idx] = d < NOPE ? bf2f(KN[kr * 512 + h * NOPE + d]) : bf2f(KPE[kr * ROPE + (d - NOPE)]); }
        for (int idx = tid; idx < 64 * VDIM; idx += NTHREADS) { const int key = idx / VDIM, d = idx % VDIM; Vs[idx] = bf2f(V[((size_t)b * SEQ + 64 * j + key) * 512 + h * VDIM + d]); }
        __syncthreads();
        for (int key = 0; key < 64; ++key) {
            if (64 * j + key <= qrow) {
                float s = 0.f;
#pragma unroll
                for (int d = 0; d < QHD; ++d) s += q[d] * Ks[key * QHD + d];
                if (s > mx) { const float al = exp2f(mx - s); l *= al;
#pragma unroll
                    for (int d = 0; d < VDIM; ++d) o[d] *= al;
                    mx = s; }
                const float p = exp2f(s - mx); l += p;
#pragma unroll
                for (int d = 0; d < VDIM; ++d) o[d] += p * Vs[key * VDIM + d];
            }
        }
    }
    const float rl = 1.f / l;
#pragma unroll
    for (int d = 0; d < VDIM; d += 2) { const float y0 = o[d] * rl * bf2f(GM[grow * 512 + h * VDIM + d]), y1 = o[d + 1] * rl * bf2f(GM[grow * 512 + h * VDIM + d + 1]);
        *(unsigned*)(Y + grow * DMODEL + h * VDIM + d) = pk2(y0, y1); }
    __syncthreads();
}
__device__ __forceinline__ void naive_scan_unit(int unit, const Args& a, LAS unsigned char* lds) {
    const int tid = tid_opaque();
    unsigned char* ws = a.ws;
    const bf16* QG = (const bf16*)(ws + WS_QG); const bf16* KG = (const bf16*)(ws + WS_KG); const bf16* HV = (const bf16*)(ws + WS_HV);
    const float* ER = (const float*)(ws + WS_ER); const float* EER = (const float*)(ws + WS_EER); float* OS = (float*)(ws + WS_OS);
    const int h = unit & 3, b = unit >> 2;
    LAS float* kgs = (LAS float*)lds; LAS float* qgs = kgs + 128; LAS float* vs = qgs + 128; LAS float* part = vs + 128; LAS float* ers = part + 512; LAS float* eers = ers + 128;
    const int v = tid & 127, kq = tid >> 7;
    float S[32];
#pragma unroll
    for (int i = 0; i < 32; ++i) S[i] = 0.f;
    for (int c = 0; c < NCHUNK; ++c) {
        const size_t gch = (size_t)b * NCHUNK + c;
        __syncthreads();
        if (tid < 128) ers[tid] = ER[gch * HGW + h * HGD + tid]; else if (tid < 256) eers[tid - 128] = EER[gch * HGW + h * HGD + tid - 128];
        __syncthreads();
#pragma unroll
        for (int i = 0; i < 32; ++i) S[i] *= ers[kq * 32 + i];
        for (int t = 0; t < CHUNK; ++t) {
            const size_t row = (size_t)b * SEQ + c * CHUNK + t;
            if (tid < 128) kgs[tid] = bf2f(KG[row * HGW + h * HGD + tid]); else if (tid < 256) qgs[tid - 128] = bf2f(QG[row * HGW + h * HGD + tid - 128]); else if (tid < 384) vs[tid - 256] = bf2f(HV[row * HGW + h * HGD + tid - 256]);
            __syncthreads();
            const float vv = vs[v]; float po = 0.f;
#pragma unroll
            for (int i = 0; i < 32; ++i) { S[i] += kgs[kq * 32 + i] * vv; po += S[i] * qgs[kq * 32 + i]; }
            part[kq * 128 + v] = po;
            __syncthreads();
            if (tid < 128) OS[row * HGW + h * HGD + tid] = (part[tid] + part[128 + tid]) + (part[256 + tid] + part[384 + tid]);
        }
#pragma unroll
        for (int i = 0; i < 32; ++i) S[i] *= eers[kq * 32 + i];
    }
    __syncthreads();
}
__device__ __forceinline__ void scan_norm_phase(const Args& a, int vcu, int G) {
    const int tid = tid_opaque(), lane = tid & 63, wave = __builtin_amdgcn_readfirstlane(tid >> 6);
    unsigned char* ws = a.ws; const float* OS = (const float*)(ws + WS_OS); const bf16* GH = (const bf16*)(ws + WS_GHG); bf16* Y = (bf16*)(ws + WS_Y);
    const int gw = vcu * NWAVES + wave, NGW = G * NWAVES;
    for (int idx = gw; idx < MTOK * HGH; idx += NGW) { const size_t row = idx >> 2; const int h = idx & 3, c = h * HGD + 2 * lane;
        const float2 o = *(const float2*)(OS + row * HGW + c); const float rstd = rsqrtf(wave_sum(o.x * o.x + o.y * o.y) * (1.f / HGD) + EPS);
        const unsigned gg = *(const unsigned*)(GH + row * HGW + c);
        const float y0 = o.x * rstd * a.hg_ng[c] * bf2f((bf16)(gg & 0xffffu)), y1 = o.y * rstd * a.hg_ng[c + 1] * bf2f((bf16)(gg >> 16));
        *(unsigned*)(Y + row * DMODEL + MLAW + c) = pk2(y0, y1); }
}
__device__ __forceinline__ void final_norm_phase(const Args& a, int vcu, int G) {
    const int tid = tid_opaque(), lane = tid & 63, wave = __builtin_amdgcn_readfirstlane(tid >> 6);
    const float* SSQO = (const float*)(a.ws + WS_SSQO);
    const int gw = vcu * NWAVES + wave, NGW = G * NWAVES;
    f32x4 gv[4];
#pragma unroll
    for (int j = 0; j < 4; ++j) gv[j] = *((const f32x4*)a.fn_g + lane + 64 * j);
    for (int m = gw; m < MTOK; m += NGW) {
        float s = (lane < 16) ? SSQO[(size_t)m * 16 + lane] : 0.f; s = wave_sum(s);
        const float rstd = rsqrtf(s * (1.f / DMODEL) + EPS);
        GAS f32x4* orow = (GAS f32x4*)(a.out + (size_t)m * DMODEL) + lane;
#pragma unroll
        for (int j = 0; j < 4; ++j) { const f32x4 v = orow[64 * j]; orow[64 * j] = v * rstd * gv[j]; }
    }
}

namespace at {
typedef short bf16x8 __attribute__((ext_vector_type(8)));
typedef short s16x4 __attribute__((ext_vector_type(4)));
typedef short v4i16_t __attribute__((ext_vector_type(4)));
typedef float f32x16 __attribute__((ext_vector_type(16)));
typedef float f32x4 __attribute__((ext_vector_type(4)));
typedef unsigned u32x4 __attribute__((ext_vector_type(4)));
typedef LAS const char* lcp;
constexpr int QB = 256, KVBLK = 64, KROW = 208  , KBUF = 64 * KROW, VBUF = 64 * 128;
constexpr int L_K = 0, L_V = 2 * KBUF, L_WS = L_V + 2 * VBUF, L_OST = L_WS + 8 * 256, L_END = L_OST + 8 * 8192;
constexpr float THR = 8.f;
#define SBAR() __builtin_amdgcn_sched_barrier(0)
#define MFMA32(a, b, c) __builtin_amdgcn_mfma_f32_32x32x16_bf16(a, b, c, 0, 0, 0)
__device__ __forceinline__ int crow(int r, int hi) { return (r & 3) + 8 * (r >> 2) + 4 * hi; }
__device__ __forceinline__ unsigned cvtpk(float lo, float hi) { unsigned r; asm volatile("v_cvt_pk_bf16_f32 %0, %1, %2" : "=v"(r) : "v"(lo), "v"(hi)); return r; }
__device__ __forceinline__ s16x4 vtr(lcp p) { return __builtin_bit_cast(s16x4, __builtin_amdgcn_ds_read_tr16_b64_v4i16((LAS v4i16_t*)p)); }
__device__ __forceinline__ void mask_tile(f32x16& p0, f32x16& p1, int dq) {
    const float NEG = -__builtin_inff();
#pragma unroll
    for (int r = 0; r < 16; ++r) { const int c = (r & 3) + 8 * (r >> 2); if (dq - c < 0) p0[r] = NEG; if (dq - c - 32 < 0) p1[r] = NEG; }
}
__device__ __forceinline__ void partialSM(f32x16& p0, f32x16& p1, float& m_reg, float& alpha) {
    float pmax = p0[0];
#pragma unroll
    for (int r = 1; r < 16; ++r) pmax = fmaxf(pmax, p0[r]);
#pragma unroll
    for (int r = 0; r < 16; ++r) pmax = fmaxf(pmax, p1[r]);
    { auto rr = __builtin_amdgcn_permlane32_swap(__float_as_uint(pmax), __float_as_uint(pmax), false, false); pmax = fmaxf(__uint_as_float(rr[0]), __uint_as_float(rr[1])); }
    float mn;
    if (__builtin_expect(__all(pmax - m_reg <= THR), 1)) { mn = m_reg; alpha = 1.f; }
    else { mn = fmaxf(m_reg, pmax); alpha = __builtin_amdgcn_exp2f(m_reg - mn); m_reg = mn; }
#pragma unroll
    for (int r = 0; r < 16; ++r) { p0[r] -= mn; p1[r] -= mn; }
#pragma unroll
    for (int r = 0; r < 16; ++r) p0[r] = __builtin_amdgcn_exp2f(p0[r]);
}
__device__ __forceinline__ void finishSM(f32x16& p0, f32x16& p1, float alpha, float& l_reg, bf16x8& pa0, bf16x8& pa1, bf16x8& pa2, bf16x8& pa3) {
#pragma unroll
    for (int r = 0; r < 16; ++r) p1[r] = __builtin_amdgcn_exp2f(p1[r]);
    float ps = 0.f;
#pragma unroll
    for (int r = 0; r < 16; ++r) ps += p0[r];
#pragma unroll
    for (int r = 0; r < 16; ++r) ps += p1[r];
    { auto rr = __builtin_amdgcn_permlane32_swap(__float_as_uint(ps), __float_as_uint(ps), false, false); ps = __uint_as_float(rr[0]) + __uint_as_float(rr[1]); }
    l_reg = l_reg * alpha + ps;
#define PK4(P, B_, OUT) do { unsigned a0 = cvtpk(P[B_+0], P[B_+1]), a1 = cvtpk(P[B_+2], P[B_+3]); unsigned b0 = cvtpk(P[B_+4], P[B_+5]), b1 = cvtpk(P[B_+6], P[B_+7]); \
        auto r0 = __builtin_amdgcn_permlane32_swap(a0, b0, false, false); auto r1 = __builtin_amdgcn_permlane32_swap(a1, b1, false, false); \
        u32x4 w = {r0[0], r1[0], r0[1], r1[1]}; OUT = __builtin_bit_cast(bf16x8, w); } while (0)
    PK4(p0, 0, pa0); PK4(p0, 8, pa1); PK4(p1, 0, pa2); PK4(p1, 8, pa3);
#undef PK4
}
template <int KB> __device__ __forceinline__ void qkt(f32x16& p0, f32x16& p1, lcp kp, const bf16x8* qr) {
    p0 = f32x16{}; p1 = f32x16{};
    lcp a = kp + KB * KBUF;
#pragma unroll
    for (int d0 = 0; d0 < 6; ++d0) {
        const bf16x8 b0 = *(const LAS bf16x8*)(a + d0 * 32);
        const bf16x8 b1 = *(const LAS bf16x8*)(a + d0 * 32 + 32 * KROW);
        p0 = MFMA32(b0, qr[d0], p0); p1 = MFMA32(b1, qr[d0], p1);
    }
}
template <int VB> __device__ __forceinline__ void pv_tile(f32x16* o, lcp vp, bf16x8 pa0, bf16x8 pa1, bf16x8 pa2, bf16x8 pa3) {
    lcp a = vp + VB * VBUF;
#pragma unroll
    for (int d0 = 0; d0 < 2; ++d0) {
        s16x4 l0 = vtr(a + d0 * 512), h0 = vtr(a + d0 * 512 + 256), l1 = vtr(a + 2048 + d0 * 512), h1 = vtr(a + 2048 + d0 * 512 + 256);
        s16x4 l2 = vtr(a + 4096 + d0 * 512), h2 = vtr(a + 4096 + d0 * 512 + 256), l3 = vtr(a + 6144 + d0 * 512), h3 = vtr(a + 6144 + d0 * 512 + 256);
        o[d0] = MFMA32(pa0, ((bf16x8){l0[0], l0[1], l0[2], l0[3], h0[0], h0[1], h0[2], h0[3]}), o[d0]);
        o[d0] = MFMA32(pa1, ((bf16x8){l1[0], l1[1], l1[2], l1[3], h1[0], h1[1], h1[2], h1[3]}), o[d0]);
        o[d0] = MFMA32(pa2, ((bf16x8){l2[0], l2[1], l2[2], l2[3], h2[0], h2[1], h2[2], h2[3]}), o[d0]);
        o[d0] = MFMA32(pa3, ((bf16x8){l3[0], l3[1], l3[2], l3[3], h3[0], h3[1], h3[2], h3[3]}), o[d0]);
    }
}

__device__ __forceinline__ void attn_unit(int b, int h, int qb, unsigned char* ws, LAS unsigned char* lds) {
    const int tid = tid_opaque(), lane = tid & 63, r32 = lane & 31, hi = lane >> 5; const int wid = __builtin_amdgcn_readfirstlane(tid >> 6);
    const bf16* Q = (const bf16*)(ws + WS_Q); const bf16* KN = (const bf16*)(ws + WS_KN); const bf16* KPE = (const bf16*)(ws + WS_KPE); const bf16* V = (const bf16*)(ws + WS_V);
    const bf16* GM = (const bf16*)(ws + WS_GMLA); bf16* Y = (bf16*)(ws + WS_Y);
    const size_t rowbase = (size_t)b * SEQ; const int q0 = qb * QB, NT = (q0 + QB) / KVBLK;
    const int skey = tid >> 3, sch = tid & 7, pkey = (tid >> 2) & 63, pch = tid & 3; const bool pe = wid < 4;
    const bf16* kn_src = KN + (rowbase + skey) * 512 + h * NOPE + sch * 8; const bf16* v_src = V + (rowbase + skey) * 512 + h * VDIM + sch * 8;
    const bf16* kp_src = KPE + (rowbase + pkey) * ROPE + pch * 8;
    LAS unsigned char* kn_dst = lds + L_K + skey * KROW + sch * 16; LAS unsigned char* kp_dst = lds + L_K + pkey * KROW + 128 + pch * 16;
    LAS unsigned char* v_dst = lds + L_V + ((skey >> 3) * 2 + (sch >> 2)) * 512 + (skey & 7) * 64 + (sch & 3) * 16;
    bf16x8 st_kn, st_kp, st_v;
#define SLOAD(t) do { st_kn = *(const bf16x8*)(kn_src + (size_t)(t) * KVBLK * 512); st_v = *(const bf16x8*)(v_src + (size_t)(t) * KVBLK * 512); if (pe) st_kp = *(const bf16x8*)(kp_src + (size_t)(t) * KVBLK * ROPE); } while (0)
#define SWRITE(bf) do { *(LAS bf16x8*)(kn_dst + (bf) * KBUF) = st_kn; *(LAS bf16x8*)(v_dst + (bf) * VBUF) = st_v; if (pe) *(LAS bf16x8*)(kp_dst + (bf) * KBUF) = st_kp; } while (0)
    lcp kp = (lcp)lds + L_K + r32 * KROW + hi * 16;
    lcp vp = (lcp)lds + L_V + hi * 1024 + ((lane >> 2) & 3) * 64 + ((lane >> 4) & 1) * 32 + (lane & 3) * 8;
    LAS float* wsf = (LAS float*)(lds + L_WS) + wid * 64; LAS float* li_l = wsf; LAS float* al_l = wsf + 32;
    bf16x8 qr[6];
    { const bf16* qw = Q + (rowbase + q0 + wid * 32 + r32) * NQ + h * QHD + hi * 8;
#pragma unroll
      for (int d0 = 0; d0 < 6; ++d0) qr[d0] = *(const bf16x8*)(qw + d0 * 16); }
    const int qlo = q0 + wid * 32, qm = qlo + r32 - 4 * hi;
    float m_reg = -1e30f, l_reg = 0.f; f32x16 o[2]; o[0] = f32x16{}; o[1] = f32x16{};
#define MASKT(P0_, P1_, t) do { const int kb_ = (t) * KVBLK; if (kb_ + KVBLK - 1 > qlo) mask_tile(P0_, P1_, qm - kb_); } while (0)
#define RESC(a_) do { if (__any((a_) < 1.f)) { if (hi == 0) al_l[r32] = (a_); \
        _Pragma("unroll") for (int d_ = 0; d_ < 2; ++d_) _Pragma("unroll") for (int r = 0; r < 16; ++r) o[d_][r] *= al_l[crow(r, hi)]; } } while (0)
    f32x16 pA0, pA1, pB0, pB1; float alA, alB; bf16x8 pa0, pa1, pa2, pa3;
    __syncthreads();
    SLOAD(0); SWRITE(0); SLOAD(1);
    __syncthreads();
    qkt<0>(pA0, pA1, kp, qr); MASKT(pA0, pA1, 0); partialSM(pA0, pA1, m_reg, alA);
    SWRITE(1);
    __syncthreads();
#define HALF_STEP(PX0, PX1, alX, PY0, PY1, alY, t, KB, VB) do { \
        SBAR(); qkt<KB>(PX0, PX1, kp, qr); \
        finishSM(PY0, PY1, alY, l_reg, pa0, pa1, pa2, pa3); SBAR(); \
        if ((t) + 1 < NT) { SLOAD((t) + 1); } SBAR(); \
        pv_tile<VB>(o, vp, pa0, pa1, pa2, pa3); MASKT(PX0, PX1, (t)); partialSM(PX0, PX1, m_reg, alX); \
        __syncthreads(); \
        if ((t) + 1 < NT) { SWRITE(VB); } \
        RESC(alX); __syncthreads(); } while (0)
    for (int t = 1; t + 1 < NT; t += 2) {
        HALF_STEP(pB0, pB1, alB, pA0, pA1, alA, t, 1, 0);
        HALF_STEP(pA0, pA1, alA, pB0, pB1, alB, t + 1, 0, 1);
    }
    SBAR(); qkt<1>(pB0, pB1, kp, qr);
    finishSM(pA0, pA1, alA, l_reg, pa0, pa1, pa2, pa3); SBAR();
    pv_tile<0>(o, vp, pa0, pa1, pa2, pa3);
    MASKT(pB0, pB1, NT - 1); partialSM(pB0, pB1, m_reg, alB); RESC(alB);
    finishSM(pB0, pB1, alB, l_reg, pa0, pa1, pa2, pa3); SBAR();
    pv_tile<1>(o, vp, pa0, pa1, pa2, pa3);
    if (hi == 0) li_l[r32] = l_reg;
    LAS float* stg = (LAS float*)(lds + L_OST) + wid * 2048;
#pragma unroll
    for (int r = 0; r < 16; ++r) { const int orow = crow(r, hi); const float rl = __builtin_amdgcn_rcpf(li_l[orow]);
#pragma unroll
        for (int d0 = 0; d0 < 2; ++d0) stg[orow * 64 + d0 * 32 + r32] = o[d0][r] * rl; }
#pragma unroll
    for (int i = 0; i < 4; ++i) { const int row = i * 8 + (lane >> 3), ch = lane & 7; const size_t grow = rowbase + q0 + wid * 32 + row;
        const f32x4 x0 = *(const LAS f32x4*)(stg + row * 64 + ch * 8), x1 = *(const LAS f32x4*)(stg + row * 64 + ch * 8 + 4);
        const u32x4 g = *(const u32x4*)(GM + grow * 512 + h * VDIM + ch * 8);
        u32x4 w;
        w.x = cvtpk(x0[0] * __uint_as_float(g.x << 16), x0[1] * __uint_as_float(g.x & 0xffff0000u)); w.y = cvtpk(x0[2] * __uint_as_float(g.y << 16), x0[3] * __uint_as_float(g.y & 0xffff0000u));
        w.z = cvtpk(x1[0] * __uint_as_float(g.z << 16), x1[1] * __uint_as_float(g.z & 0xffff0000u)); w.w = cvtpk(x1[2] * __uint_as_float(g.w << 16), x1[3] * __uint_as_float(g.w & 0xffff0000u));
        *(u32x4*)(Y + grow * DMODEL + h * VDIM + ch * 8) = w; }
#undef SLOAD
#undef SWRITE
#undef MASKT
#undef RESC
#undef HALF_STEP
}
#undef SBAR
#undef MFMA32
}

#ifndef MK_PER_PHASE
#define MK_PER_PHASE 0
#endif
#ifndef NAIVE_ATTN
#define NAIVE_ATTN 0
#endif
#ifndef NAIVE_SCAN
#define NAIVE_SCAN 1
#endif
#if NAIVE_SCAN
#define SCAN_UNIT(u) naive_scan_unit((u), a, lds)
#endif
constexpr int N_PHASES = 7;
__global__ void __launch_bounds__(NTHREADS, 2) hyb_fwd(Args a) {
    extern __shared__ __attribute__((aligned(16))) unsigned char lds_raw[];
    LAS unsigned char* lds = (LAS unsigned char*)lds_raw;
    const int G = gridDim.x; const int bx = blockIdx.x; const int vcu = (G % 8 == 0) ? (bx % 8) * (G / 8) + bx / 8 : bx;
    unsigned char* ws = a.ws;
    gu32* ctl = (gu32*)(ws + WS_CTL);
    volatile LAS unsigned* MISC = (volatile LAS unsigned*)(lds + MISC_OFF);
    for (int u = threadIdx.x; u < (LDS_BYTES - LDSCTL_OFF) / 4; u += NTHREADS) ((LAS unsigned*)(lds + LDSCTL_OFF))[u] = 0u;
    __syncthreads();
    const int lo = a.ph_lo, hi = a.ph_hi;
    const bool fusedl = (hi - lo) > 1;
    XcdBarrier bar; bar.bar = (unsigned*)(ctl + CW_BAR); bar.x = 0; bar.st = nullptr;
    if (fusedl) bar = xcd_barrier_post((unsigned*)(ctl + CW_BAR), MISC + 8);
#define IN(k) (lo <= (k) && (k) < hi)
#define SEAM(k) do { if (IN(k) && IN((k) + 1)) xcd_barrier(bar); } while (0)

#ifndef NO_P0
    if (IN(0)) { p0_prologue(a, lds, vcu, G); SEAM(0); }
#endif

#ifndef NO_P1
    if (IN(1)) {
        pg8::Gemm g{(const bf16*)(ws + WS_XN), (const bf16*)(ws + WS_W1T), MTOK, N1, DMODEL}; pg8::StaticOrder S; S.init(MTOK, N1, G, bx);
        pg8::EpiP1 E{ws};
        pg8::gemm_phase<pg8::EpiP1, pg8::StaticOrder, true, PG8_SP2>(lds, g, S, E);
        SEAM(1);
    }
#endif
#ifndef NO_P2
    if (IN(2)) {
        { pg8::Gemm g{(const bf16*)(ws + WS_QLAT), (const bf16*)(ws + WS_WQT), MTOK, NQ, QRANK}; pg8::StaticOrder S; S.init(MTOK, NQ, G, bx);
          pg8::EpiQ E{(bf16*)(ws + WS_Q), (const float*)(ws + WS_SSQQ), (const pg8::f32x2e*)(ws + WS_CS)};
          pg8::gemm_phase<pg8::EpiQ, pg8::StaticOrder, true, PG8_SP2>(lds, g, S, E); }
        { pg8::Gemm g{(const bf16*)(ws + WS_KVLAT), (const bf16*)(ws + WS_WKVT), MTOK, NKV, KVRANK}; pg8::StaticOrder S; S.init(MTOK, NKV, G, bx);
          pg8::EpiKV E{(bf16*)(ws + WS_KN), (bf16*)(ws + WS_V), (const float*)(ws + WS_SSQKV)};
          pg8::gemm_phase<pg8::EpiKV, pg8::StaticOrder, true, PG8_SP2>(lds, g, S, E); }
        SEAM(2);
    }
#endif
#ifndef NO_P3
    if (IN(3)) {
#if NAIVE_ATTN
        if (bx < BATCH * HGH) naive_scan_unit(bx, a, lds);
        for (int u = bx; u < BATCH * NHEAD * (SEQ / 512); u += G) naive_attn_unit(u, a, lds);
#else
        const unsigned xq = xb_xcc_id() & 7u;
        for (unsigned qi = 0; qi < 8; ++qi) { const unsigned q = (xq + qi) & 7u;
            for (;;) {
                __syncthreads();
                if (threadIdx.x == 0) MISC[16] = __hip_atomic_fetch_add(ctl + CW_QUEUE + 64 * q, 1u, __ATOMIC_RELAXED, __HIP_MEMORY_SCOPE_AGENT);
                __syncthreads();
                const unsigned k = MISC[16];
                if (k >= 4 + 128) break;
                if (k < 4) SCAN_UNIT((int)(q * 4 + k));
                else { const unsigned k2 = k - 4, bh = q * 8 + (k2 & 7); at::attn_unit((int)(bh >> 3), (int)(bh & 7), 15 - (int)(k2 >> 3), ws, lds); }
            }
        }
#endif
        SEAM(3);
    }
#endif
    if (IN(4)) { scan_norm_phase(a, vcu, G); SEAM(4); }
#ifndef NO_P5
    if (IN(5)) {
        pg8::Gemm g{(const bf16*)(ws + WS_Y), (const bf16*)(ws + WS_WOT), MTOK, DMODEL, DMODEL}; pg8::StaticOrder S; S.init(MTOK, DMODEL, G, bx);
        pg8::EpiOut E{a.x, a.out, (float*)(ws + WS_SSQO)};
        pg8::gemm_phase<pg8::EpiOut, pg8::StaticOrder, true, PG8_SP2>(lds, g, S, E);
        SEAM(5);
    }
#endif
    if (IN(6)) final_norm_phase(a, vcu, G);
#undef IN
#undef SEAM
}

extern "C" void kernel_launch(void* const* d_in, const int* in_sizes, int n_in, void* d_out, int out_size, void* d_ws, size_t ws_size, hipStream_t stream) {
    static int grid = 0;
    if (grid == 0) {
        if (n_in != 12 || in_sizes[0] != MTOK * DMODEL || out_size != MTOK * DMODEL || ws_size < WS_END) { fprintf(stderr, "kernel_launch: unexpected shapes (n_in %d, in0 %d, out %d, ws %zu); nothing launched\n", n_in, n_in > 0 ? in_sizes[0] : -1, out_size, ws_size); grid = -1; return; }
        int dev = 0, cus = 0, per_cu = 0;
        if (hipGetDevice(&dev) != hipSuccess || hipDeviceGetAttribute(&cus, hipDeviceAttributeMultiprocessorCount, dev) != hipSuccess) { fprintf(stderr, "kernel_launch: device query failed\n"); grid = -1; return; }
        if (hipFuncSetAttribute((const void*)hyb_fwd, hipFuncAttributeMaxDynamicSharedMemorySize, LDS_BYTES) != hipSuccess) { fprintf(stderr, "kernel_launch: hipFuncSetAttribute failed\n"); grid = -1; return; }
        if (hipOccupancyMaxActiveBlocksPerMultiprocessor(&per_cu, (const void*)hyb_fwd, NTHREADS, LDS_BYTES) != hipSuccess || per_cu < 1) { fprintf(stderr, "kernel_launch: occupancy query reports %d workgroups per CU\n", per_cu); per_cu = 1; }
        (void)hipGetLastError();
        grid = cus;
    }
    if (grid < 0) return;
    if (hipMemsetAsync((char*)d_ws + WS_CTL, 0, CTL_ZERO_BYTES, stream) != hipSuccess) { fprintf(stderr, "kernel_launch: hipMemsetAsync failed\n"); return; }
    Args a{};
    a.x = (const float*)d_in[0]; a.pos = (const int*)d_in[1]; a.ln_g = (const float*)d_in[2]; a.w_in = (const float*)d_in[3]; a.qn_g = (const float*)d_in[4]; a.w_q_b = (const float*)d_in[5];
    a.kvn_g = (const float*)d_in[6]; a.w_kv_b = (const float*)d_in[7]; a.hg_lb = (const float*)d_in[8]; a.hg_ng = (const float*)d_in[9]; a.w_out = (const float*)d_in[10]; a.fn_g = (const float*)d_in[11];
    a.out = (float*)d_out; a.ws = (unsigned char*)d_ws;
#if MK_PER_PHASE
    for (int p = 0; p < N_PHASES; ++p) { a.ph_lo = p; a.ph_hi = p + 1; hipLaunchKernelGGL(hyb_fwd, dim3(grid), dim3(NTHREADS), LDS_BYTES, stream, a); }
#else
    a.ph_lo = 0; a.ph_hi = N_PHASES; hipLaunchKernelGGL(hyb_fwd, dim3(grid), dim3(NTHREADS), LDS_BYTES, stream, a);
#endif
    const hipError_t le = hipPeekAtLastError();
    if (le != hipSuccess) fprintf(stderr, "kernel_launch: launch failed: %s\n", hipGetErrorName(le));
}
```

```cpp
#include <hip/hip_runtime.h>
#include <hip/hip_bf16.h>
#include <cstdio>
#include <cstdint>

constexpr int BATCH = 8, SEQ = 4096, DMODEL = 1024, MTOK = BATCH * SEQ;
constexpr int D_IN = 2976, N1 = 3072;
constexpr int NHEAD = 8, NOPE = 64, ROPE = 32, VDIM = 64, QRANK = 256, KVRANK = 128, QHD = NOPE + ROPE;
constexpr int NQ = NHEAD * QHD  , NKV = NHEAD * (NOPE + VDIM)  , MLAW = NHEAD * VDIM  ;
constexpr int HGH = 4, HGD = 128, HGW = 512, CHUNK = 64, NCHUNK = SEQ / CHUNK;
constexpr float EPS = 1e-6f;
constexpr float QSCALE = 0.1472444460259031f;
constexpr int C_QLAT = 0, C_KVLAT = 256, C_KROPE = 384, C_GMLA = 416, C_HQ = 928, C_HF = 1440, C_HI = 1952, C_GHG = 2464;

constexpr size_t MiB = 1u << 20;
constexpr size_t WS_CTL = 0, CTL_ZERO_BYTES = 64 * 1024;
constexpr size_t WS_W1T = 2 * MiB;
constexpr size_t WS_WQT = 8 * MiB;
constexpr size_t WS_WKVT = 8 * MiB + 512 * 1024;
constexpr size_t WS_WOT = 9 * MiB;
constexpr size_t WS_CS = 11 * MiB;
constexpr size_t WS_LB = 15 * MiB;
constexpr size_t WS_SSQQ = 16 * MiB, WS_SSQKV = 16 * MiB + 512 * 1024;
constexpr size_t WS_SSQO = 17 * MiB;
constexpr size_t WS_ER = 19 * MiB, WS_EER = 20 * MiB;
constexpr size_t WS_XN = 32 * MiB;
constexpr size_t WS_Y = 32 * MiB;
constexpr size_t WS_QLAT = 96 * MiB, WS_KVLAT = 112 * MiB, WS_KPE = 120 * MiB;
constexpr size_t WS_GMLA = 128 * MiB, WS_QG = 160 * MiB, WS_KG = 192 * MiB, WS_HV = 224 * MiB, WS_GHG = 256 * MiB;
constexpr size_t WS_Q = 288 * MiB;
constexpr size_t WS_KN = 336 * MiB, WS_V = 368 * MiB;
constexpr size_t WS_OS = 400 * MiB;
constexpr size_t WS_END = 464 * MiB;
constexpr int CW_BAR = 1024;
constexpr int CW_QUEUE = 8192;
static_assert((CW_BAR + 3456) * 4 <= (int)CTL_ZERO_BYTES && (CW_QUEUE + 64 * 16) * 4 <= (int)CTL_ZERO_BYTES, "CTL words inside the memset region");

namespace pg8 {
#define PG8_LAS __attribute__((address_space(3)))
typedef unsigned short bf16_t;
typedef short bf16x8 __attribute__((ext_vector_type(8)));
typedef float f32x4 __attribute__((ext_vector_type(4)));
typedef unsigned u32x4 __attribute__((ext_vector_type(4)));
constexpr int BM = 256, BK = 64, HALF = 128, HTB = HALF * BK * 2  , STAGE_BYTES = 8 * HTB, NXCD = 8, WGM = 8;

__host__ __device__ __forceinline__ int lds_byte(int r, int c) { const int st = (r >> 4) * 2 + (c >> 5), rr = r & 15, cc = c & 31, ob = rr * 64 + cc * 2; return st * 1024 + (ob ^ (((ob >> 9) & 1) << 5)); }
__host__ __device__ __forceinline__ void stage_rc(int b, int& R, int& C) { const int st = b / 1024, sb = b % 1024, swz = sb ^ (((sb >> 9) & 1) << 5); R = (st >> 1) * 16 + swz / 64; C = (st & 1) * 32 + (swz % 64) / 2; }
__host__ __device__ __forceinline__ int perm32(int rho) { const int n = rho >> 4, i = rho & 15; return 8 * (i >> 2) + 4 * n + (i & 3); }

struct Unit { int pm, pn; };
struct Gemm { const bf16_t* A; const bf16_t* Bt; int M, N, K; };

struct StaticOrder {
    int nM, nN, nwg, G, c;
    __host__ __device__ void init(int M, int N, int G_, int c_) { nM = M / BM; nN = N / BM; nwg = nM * nN; G = G_; c = c_; }
    __host__ __device__ bool next(int i, Unit& u) const {
        const long L = (long)i * G + c; if (L >= nwg) return false;
        int wgid = (int)L; { const int q = nwg / NXCD, r = nwg % NXCD, xcd = wgid % NXCD, off = wgid / NXCD; wgid = (xcd < r ? xcd * (q + 1) : r * (q + 1) + (xcd - r) * q) + off; }
        const int nig = WGM * nN, gid = wgid / nig, fm = gid * WGM, gsz = (nM - fm) < WGM ? (nM - fm) : WGM;
        u.pm = fm + ((wgid % nig) % gsz); u.pn = (wgid % nig) / gsz; return true;
    }
    __device__ __forceinline__ void a_ready(const Unit&) const {}
    __device__ __forceinline__ void done(const Unit&) const {}
};

__device__ __forceinline__ unsigned cvt_pk_bf16(float lo, float hi) { unsigned r; asm volatile("v_cvt_pk_bf16_f32 %0, %1, %2" : "=v"(r) : "v"(lo), "v"(hi)); return r; }
typedef float f32x2e __attribute__((ext_vector_type(2)));
__device__ __forceinline__ void st8(bf16_t* p, const f32x4& a, const f32x4& b) {
    u32x4 w; w.x = cvt_pk_bf16(a[0], a[1]); w.y = cvt_pk_bf16(a[2], a[3]); w.z = cvt_pk_bf16(b[0], b[1]); w.w = cvt_pk_bf16(b[2], b[3]);
    *(u32x4*)p = w;
}
__device__ __forceinline__ float sigm(float x) { return __builtin_amdgcn_rcpf(1.0f + __expf(-x)); }
__device__ __forceinline__ float silu_f(float x) { return x * sigm(x); }
__device__ __forceinline__ f32x4 silu4(const f32x4& v) { f32x4 o; o[0] = silu_f(v[0]); o[1] = silu_f(v[1]); o[2] = silu_f(v[2]); o[3] = silu_f(v[3]); return o; }
__device__ __forceinline__ float sq4(const f32x4& v) { return (v[0] * v[0] + v[1] * v[1]) + (v[2] * v[2] + v[3] * v[3]); }
template <int SH> __device__ __forceinline__ float dpp_shr(float v) {
    return __builtin_bit_cast(float, __builtin_amdgcn_update_dpp(0, __builtin_bit_cast(int, v), 0x110 + SH, 0xf, 0xf, true));
}
__device__ __forceinline__ float scan16(float v) { v += dpp_shr<1>(v); v += dpp_shr<2>(v); v += dpp_shr<4>(v); v += dpp_shr<8>(v); return v; }
__device__ __forceinline__ float clampe(float x) { return fminf(fmaxf(x, -80.f), 80.f); }

struct EpiP1 {
    static constexpr bool PERM = true, AFTER_DRAIN = false;
    unsigned char* ws;
    __device__ __forceinline__ void operator()(const f32x4 (&acc)[2][2][4][2], const Unit& u, int wr, int wc, int fr, int fq) const {
        { int t_ = threadIdx.x; asm volatile("" : "+v"(t_)); fr = t_ & 15; fq = (t_ >> 4) & 3; }
        const int pn = u.pn, lane = fq * 16 + fr;
        bf16_t* const QLAT = (bf16_t*)(ws + WS_QLAT); bf16_t* const KVLAT = (bf16_t*)(ws + WS_KVLAT); bf16_t* const KPE = (bf16_t*)(ws + WS_KPE);
        bf16_t* const QG = (bf16_t*)(ws + WS_QG); bf16_t* const KG = (bf16_t*)(ws + WS_KG);
        float* const SSQQ = (float*)(ws + WS_SSQQ); float* const SSQKV = (float*)(ws + WS_SSQKV); float* const ER = (float*)(ws + WS_ER); float* const EER = (float*)(ws + WS_EER);
        const float* const LB = (const float*)(ws + WS_LB); const f32x2e* const CS = (const f32x2e*)(ws + WS_CS);
        const int rowb = u.pm * BM + wr * 64 + fr, cw = wc * 32 + 8 * fq;
        if (pn == 0) {
#pragma unroll
            for (int ai = 0; ai < 2; ++ai)
#pragma unroll
                for (int m = 0; m < 4; ++m) { const size_t row = (size_t)(rowb + ai * HALF + m * 16); float s = 0.f;
#pragma unroll
                    for (int bj = 0; bj < 2; ++bj) { const f32x4 v0 = acc[ai][bj][m][0], v1 = acc[ai][bj][m][1]; s += sq4(v0) + sq4(v1); st8(QLAT + row * QRANK + bj * HALF + cw, v0, v1); }
                    s += __shfl_xor(s, 16); s += __shfl_xor(s, 32); if (fq == 0) SSQQ[row * 4 + wc] = s; }
        } else if (pn == 1) {
#pragma unroll
            for (int ai = 0; ai < 2; ++ai)
#pragma unroll
                for (int m = 0; m < 4; ++m) { const size_t row = (size_t)(rowb + ai * HALF + m * 16);
                    const f32x4 v0 = acc[ai][0][m][0], v1 = acc[ai][0][m][1]; float s = sq4(v0) + sq4(v1); st8(KVLAT + row * KVRANK + cw, v0, v1);
                    s += __shfl_xor(s, 16); s += __shfl_xor(s, 32); if (fq == 0) SSQKV[row * 4 + wc] = s;
                    if (wc == 0) {
                        const f32x4 x0 = acc[ai][1][m][0], x1 = acc[ai][1][m][1]; f32x4 p0, p1, o0, o1;
#pragma unroll
                        for (int j = 0; j < 4; ++j) { p0[j] = __shfl_xor(x0[j], 32); p1[j] = __shfl_xor(x1[j], 32); }
                        const f32x2e* cs = CS + row * 16 + 8 * (fq & 1); const float sg = (fq < 2) ? -1.f : 1.f;
#pragma unroll
                        for (int j = 0; j < 4; ++j) { const f32x2e c0 = cs[j], c1 = cs[4 + j]; o0[j] = x0[j] * c0.x + sg * p0[j] * c0.y; o1[j] = x1[j] * c1.x + sg * p1[j] * c1.y; }
                        st8(KPE + row * ROPE + 8 * fq, o0, o1);
                    } }
        } else if (pn < 4 || pn >= 8) {
            size_t doff; bool act; int colt;
            if (pn < 4) { doff = WS_GMLA; act = true; colt = (pn - 2) * BM; } else if (pn < 10) { doff = WS_HV; act = false; colt = (pn - 8) * BM; } else { doff = WS_GHG; act = true; colt = (pn - 10) * BM; }
            bf16_t* const dst = (bf16_t*)(ws + doff);
#pragma unroll
            for (int ai = 0; ai < 2; ++ai)
#pragma unroll
                for (int m = 0; m < 4; ++m) { const size_t row = (size_t)(rowb + ai * HALF + m * 16);
#pragma unroll
                    for (int bj = 0; bj < 2; ++bj) { f32x4 v0 = acc[ai][bj][m][0], v1 = acc[ai][bj][m][1]; if (act) { v0 = silu4(v0); v1 = silu4(v1); }
                        st8(dst + row * 512 + colt + bj * HALF + cw, v0, v1); } }
        } else {
            const int ch0 = (pn - 4) * HGD + cw;
#pragma unroll
            for (int ai = 0; ai < 2; ++ai) {
                const int gch = (u.pm * BM + ai * HALF + wr * 64) >> 6;
                f32x4 qo[4][2], ko[4][2];
#pragma unroll
                for (int n = 0; n < 2; ++n)
#pragma unroll
                    for (int j = 0; j < 4; ++j) { const float lb = LB[ch0 + 4 * n + j], oml = 1.f - lb;
                        float g[4], kk[4];
#pragma unroll
                        for (int m = 0; m < 4; ++m) { const float x = acc[ai][1][m][n][j]; const float f = lb + oml * sigm(x); kk[m] = oml * sigm(-x); g[m] = scan16(__logf(f)); }
                        const int l15 = (lane & 48) | 15;
                        const float t0 = __shfl(g[0], l15), t1 = __shfl(g[1], l15), t2 = __shfl(g[2], l15), t3 = __shfl(g[3], l15);
                        g[1] += t0; g[2] += t0 + t1; g[3] += (t0 + t1) + t2;
                        const float R = t0 + t1, Gend = (t0 + t1) + (t2 + t3);
#pragma unroll
                        for (int m = 0; m < 4; ++m) { const float d = clampe(g[m] - R); qo[m][n][j] = silu_f(acc[ai][0][m][n][j]) * __expf(d); ko[m][n][j] = kk[m] * __expf(-d); }
                        if (fr == 15) { ER[(size_t)gch * HGW + ch0 + 4 * n + j] = __expf(clampe(R)); EER[(size_t)gch * HGW + ch0 + 4 * n + j] = __expf(clampe(Gend - R)); }
                    }
#pragma unroll
                for (int m = 0; m < 4; ++m) { const size_t row = (size_t)(rowb + ai * HALF + m * 16); st8(QG + row * HGW + ch0, qo[m][0], qo[m][1]); st8(KG + row * HGW + ch0, ko[m][0], ko[m][1]); }
            }
        }
    }
};

struct EpiQ {
    static constexpr bool PERM = true, AFTER_DRAIN = false;
    bf16_t* Q; const float* SSQQ; const f32x2e* CS;
    __device__ __forceinline__ void operator()(const f32x4 (&acc)[2][2][4][2], const Unit& u, int wr, int wc, int fr, int fq) const {
        { int t_ = threadIdx.x; asm volatile("" : "+v"(t_)); fr = t_ & 15; fq = (t_ >> 4) & 3; }
        const int rowb = u.pm * BM + wr * 64 + fr;
#pragma unroll
        for (int ai = 0; ai < 2; ++ai)
#pragma unroll
            for (int m = 0; m < 4; ++m) { const size_t row = (size_t)(rowb + ai * HALF + m * 16);
                const f32x4 sq = *(const f32x4*)(SSQQ + row * 4); const float rs = rsqrtf(((sq[0] + sq[1]) + (sq[2] + sq[3])) * (1.f / QRANK) + EPS) * QSCALE;
#pragma unroll
                for (int bj = 0; bj < 2; ++bj) { const int g32 = u.pn * 8 + bj * 4 + wc;
                    f32x4 x0 = acc[ai][bj][m][0] * rs, x1 = acc[ai][bj][m][1] * rs;
                    if (g32 % 3 == 2) {
                        f32x4 p0, p1, o0, o1;
#pragma unroll
                        for (int j = 0; j < 4; ++j) { p0[j] = __shfl_xor(x0[j], 32); p1[j] = __shfl_xor(x1[j], 32); }
                        const f32x2e* cs = CS + row * 16 + 8 * (fq & 1); const float sg = (fq < 2) ? -1.f : 1.f;
#pragma unroll
                        for (int j = 0; j < 4; ++j) { const f32x2e c0 = cs[j], c1 = cs[4 + j]; o0[j] = x0[j] * c0.x + sg * p0[j] * c0.y; o1[j] = x1[j] * c1.x + sg * p1[j] * c1.y; }
                        x0 = o0; x1 = o1;
                    }
                    st8(Q + row * NQ + g32 * 32 + 8 * fq, x0, x1); } }
    }
};
struct EpiKV {
    static constexpr bool PERM = true, AFTER_DRAIN = false;
    bf16_t *KN, *V; const float* SSQKV;
    __device__ __forceinline__ void operator()(const f32x4 (&acc)[2][2][4][2], const Unit& u, int wr, int wc, int fr, int fq) const {
        { int t_ = threadIdx.x; asm volatile("" : "+v"(t_)); fr = t_ & 15; fq = (t_ >> 4) & 3; }
        const int rowb = u.pm * BM + wr * 64 + fr;
#pragma unroll
        for (int ai = 0; ai < 2; ++ai)
#pragma unroll
            for (int m = 0; m < 4; ++m) { const size_t row = (size_t)(rowb + ai * HALF + m * 16);
                const f32x4 sq = *(const f32x4*)(SSQKV + row * 4); const float rs = rsqrtf(((sq[0] + sq[1]) + (sq[2] + sq[3])) * (1.f / KVRANK) + EPS);
#pragma unroll
                for (int bj = 0; bj < 2; ++bj) { const int g32 = u.pn * 8 + bj * 4 + wc, h = g32 >> 2, part = g32 & 3;
                    bf16_t* dst = (part < 2 ? KN : V) + row * 512 + h * 64 + (part & 1) * 32 + 8 * fq;
                    st8(dst, acc[ai][bj][m][0] * rs, acc[ai][bj][m][1] * rs); } }
    }
};
struct EpiOut {
    static constexpr bool PERM = false, AFTER_DRAIN = false;
    const float* X; float* OUT; float* SSQO;
    __device__ __forceinline__ void operator()(const f32x4 (&acc)[2][2][4][2], const Unit& u, int wr, int wc, int fr, int fq) const {
        { int t_ = threadIdx.x; asm volatile("" : "+v"(t_)); fr = t_ & 15; fq = (t_ >> 4) & 3; }
        const int rowb = u.pm * BM + wr * 64 + fr, col0 = u.pn * BM + wc * 32 + 4 * fq;
#pragma unroll
        for (int ai = 0; ai < 2; ++ai)
#pragma unroll
            for (int m = 0; m < 4; ++m) { const size_t off = (size_t)(rowb + ai * HALF + m * 16) * DMODEL + col0; float s = 0.f;
#pragma unroll
                for (int bj = 0; bj < 2; ++bj)
#pragma unroll
                    for (int n = 0; n < 2; ++n) { const f32x4 v = acc[ai][bj][m][n] + *(const f32x4*)(X + off + bj * HALF + n * 16); s += sq4(v); *(f32x4*)(OUT + off + bj * HALF + n * 16) = v; }
                s += __shfl_xor(s, 16); s += __shfl_xor(s, 32); if (fq == 0) SSQO[(size_t)(rowb + ai * HALF + m * 16) * 16 + u.pn * 4 + wc] = s; }
    }
};
template <class Epi, class Sched, bool ALIGN_EPI = false, bool SP2 = false>
__device__ __forceinline__ void gemm_phase(PG8_LAS unsigned char* lds, const Gemm g, const Sched& S, const Epi& E) {
    int tid_ = threadIdx.x; asm volatile("" : "+v"(tid_));
    const int tid = tid_, wid = __builtin_amdgcn_readfirstlane(tid >> 6), lane = tid & 63, wr = wid >> 2, wc = wid & 3, fr = lane & 15, fq = lane >> 4;
    const int K = g.K, nt = K / BK;
    unsigned voffA[2], voffB[2];
#pragma unroll
    for (int i = 0; i < 2; ++i) { int R, C; stage_rc(tid * 16 + i * 8192, R, C); const int Rb = Epi::PERM ? ((R & ~31) + perm32(R & 31)) : R;
        voffA[i] = (unsigned)(R * K + C) * 2u; voffB[i] = (unsigned)(Rb * K + C) * 2u; }
    const size_t kstep = (size_t)(BK * 2);
    const size_t hstep = (size_t)HALF * K * 2;
    const size_t tstep = 2 * hstep;
    const unsigned ldsw = (unsigned)wid * 1024u;
    const int aoff = lds_byte(wr * 64 + fr, fq * 8), boff = lds_byte(wc * 32 + fr, fq * 8);
#define PG8_SA(b, h) (((b) * 2 + (h)) * HTB)
#define PG8_SB(b, h) ((4 + (b) * 2 + (h)) * HTB)
#define PG8_STAGE(bufoff, gbase, voff) do { _Pragma("unroll") for (int _i = 0; _i < 2; ++_i) \
        __builtin_amdgcn_global_load_lds((const unsigned*)((const char*)(gbase) + (voff)[_i]), (PG8_LAS unsigned*)(lds + (bufoff) + ldsw + _i * 8192), 16, 0, 0); } while (0)
#define PG8_LDA(dst, b, h) do { _Pragma("unroll") for (int m = 0; m < 4; ++m) _Pragma("unroll") for (int k = 0; k < 2; ++k) dst[m][k] = *(const PG8_LAS bf16x8*)(lds + PG8_SA(b, h) + aoff + m * 2048 + k * 1024); } while (0)
#define PG8_LDB(dst, b, h) do { _Pragma("unroll") for (int n = 0; n < 2; ++n) _Pragma("unroll") for (int k = 0; k < 2; ++k) dst[n][k] = *(const PG8_LAS bf16x8*)(lds + PG8_SB(b, h) + boff + n * 2048 + k * 1024); } while (0)
#define PG8_MMA(ai, bj, At, Bt) do { __builtin_amdgcn_s_setprio(1); _Pragma("unroll") for (int m = 0; m < 4; ++m) _Pragma("unroll") for (int n = 0; n < 2; ++n) _Pragma("unroll") for (int k = 0; k < 2; ++k) \
        acc[ai][bj][m][n] = __builtin_amdgcn_mfma_f32_16x16x32_bf16(Bt[n][k], At[m][k], acc[ai][bj][m][n], 0, 0, 0); __builtin_amdgcn_s_setprio(0); } while (0)
#define PG8_WAIT_V(n) asm volatile("s_waitcnt vmcnt(" #n ")" ::: "memory")
#define PG8_WAIT_L(n) asm volatile("s_waitcnt lgkmcnt(" #n ")" ::: "memory")
#define PG8_BAR __builtin_amdgcn_s_barrier()
#define PG8_SCHED __builtin_amdgcn_sched_barrier(0)
    Unit cur, nxt; int ui = 0;
    if (!S.next(0, cur)) return;
    f32x4 acc[2][2][4][2];
#pragma unroll
    for (int a = 0; a < 2; ++a)
#pragma unroll
        for (int b = 0; b < 2; ++b)
#pragma unroll
            for (int m = 0; m < 4; ++m)
#pragma unroll
                for (int n = 0; n < 2; ++n) acc[a][b][m][n] = (f32x4){0.f, 0.f, 0.f, 0.f};
    bf16x8 At[4][2], B0[2][2], B1[2][2];
    const char* cA = (const char*)g.A + (size_t)cur.pm * tstep; const char* cB = (const char*)g.Bt + (size_t)cur.pn * tstep;
    S.a_ready(cur);
    if constexpr (SP2) {
        PG8_STAGE(PG8_SB(0, 0), cB, voffB); PG8_STAGE(PG8_SB(0, 1), cB + hstep, voffB); PG8_STAGE(PG8_SA(0, 0), cA, voffA); PG8_STAGE(PG8_SA(0, 1), cA + hstep, voffA);
        if (wr == 1) PG8_BAR;
        PG8_WAIT_V(2); PG8_BAR;
        PG8_STAGE(PG8_SB(1, 0), cB + kstep, voffB); PG8_STAGE(PG8_SA(1, 0), cA + kstep, voffA); PG8_STAGE(PG8_SB(1, 1), cB + hstep + kstep, voffB);
        PG8_WAIT_V(6); PG8_BAR;
    } else {
        PG8_STAGE(PG8_SB(0, 0), cB, voffB); PG8_STAGE(PG8_SA(0, 0), cA, voffA); PG8_STAGE(PG8_SB(0, 1), cB + hstep, voffB); PG8_STAGE(PG8_SA(0, 1), cA + hstep, voffA);
        if (wr == 1) PG8_BAR;
        PG8_WAIT_V(4); PG8_BAR;
        PG8_STAGE(PG8_SB(1, 0), cB + kstep, voffB); PG8_STAGE(PG8_SA(1, 0), cA + kstep, voffA); PG8_STAGE(PG8_SB(1, 1), cB + hstep + kstep, voffB);
        PG8_WAIT_V(6); PG8_BAR;
    }
    for (;;) {
        const bool has_next = S.next(ui + 1, nxt);
        const char* nA = has_next ? (const char*)g.A + (size_t)nxt.pm * tstep : cA; const char* nB = has_next ? (const char*)g.Bt + (size_t)nxt.pn * tstep : cB;
        for (int t = 0; t < nt; t += 2) {
            const bool last = (t == nt - 2);
            const char* a1 = cA + (size_t)(t + 1) * kstep;
            const char* a2 = last ? nA : cA + (size_t)(t + 2) * kstep; const char* b2 = last ? nB : cB + (size_t)(t + 2) * kstep;
            const char* a3 = a2 + kstep; const char* b3 = b2 + kstep;
            if (last && has_next) S.a_ready(nxt);
            if constexpr (SP2) {
            PG8_LDB(B0, 0, 0); PG8_LDB(B1, 0, 1); PG8_SCHED; PG8_LDA(At, 0, 0); PG8_STAGE(PG8_SA(1, 1), a1 + hstep, voffA);
            PG8_WAIT_V(8); PG8_WAIT_L(0); PG8_BAR; PG8_MMA(0, 0, At, B0); PG8_MMA(0, 1, At, B1); PG8_BAR; PG8_SCHED;
            PG8_LDA(At, 0, 1); PG8_STAGE(PG8_SB(0, 0), b2, voffB); PG8_STAGE(PG8_SB(0, 1), b2 + hstep, voffB); PG8_STAGE(PG8_SA(0, 0), a2, voffA);
            PG8_WAIT_V(8); PG8_WAIT_L(0); PG8_BAR; PG8_MMA(1, 0, At, B0); PG8_MMA(1, 1, At, B1); PG8_BAR; PG8_SCHED;
            PG8_LDB(B0, 1, 0); PG8_LDB(B1, 1, 1); PG8_SCHED; PG8_LDA(At, 1, 0); PG8_STAGE(PG8_SA(0, 1), a2 + hstep, voffA);
            PG8_WAIT_V(8); PG8_WAIT_L(0); PG8_BAR; PG8_MMA(0, 0, At, B0); PG8_MMA(0, 1, At, B1); PG8_BAR; PG8_SCHED;
            PG8_LDA(At, 1, 1); PG8_STAGE(PG8_SB(1, 0), b3, voffB); PG8_STAGE(PG8_SB(1, 1), b3 + hstep, voffB); PG8_STAGE(PG8_SA(1, 0), a3, voffA);
            PG8_WAIT_V(8); PG8_WAIT_L(0); PG8_BAR; PG8_MMA(1, 0, At, B0); PG8_MMA(1, 1, At, B1); PG8_BAR; PG8_SCHED;
            } else {
            PG8_LDB(B0, 0, 0); PG8_SCHED; PG8_LDA(At, 0, 0); PG8_STAGE(PG8_SA(1, 1), a1 + hstep, voffA);
            PG8_WAIT_L(8); PG8_BAR; PG8_WAIT_L(0); PG8_MMA(0, 0, At, B0); PG8_BAR; PG8_SCHED;
            PG8_LDB(B1, 0, 1); PG8_STAGE(PG8_SB(0, 0), b2, voffB);
            PG8_BAR; PG8_WAIT_L(0); PG8_MMA(0, 1, At, B1); PG8_BAR;
            PG8_LDA(At, 0, 1); PG8_STAGE(PG8_SA(0, 0), a2, voffA);
            PG8_BAR; PG8_WAIT_L(0); PG8_MMA(1, 0, At, B0); PG8_BAR; PG8_SCHED;
            PG8_STAGE(PG8_SB(0, 1), b2 + hstep, voffB);
            PG8_WAIT_V(6); PG8_BAR; PG8_MMA(1, 1, At, B1); PG8_BAR;
            PG8_LDB(B0, 1, 0); PG8_SCHED; PG8_LDA(At, 1, 0); PG8_STAGE(PG8_SA(0, 1), a2 + hstep, voffA);
            PG8_WAIT_L(8); PG8_BAR; PG8_WAIT_L(0); PG8_MMA(0, 0, At, B0); PG8_BAR; PG8_SCHED;
            PG8_LDB(B1, 1, 1); PG8_STAGE(PG8_SB(1, 0), b3, voffB);
            PG8_BAR; PG8_WAIT_L(0); PG8_MMA(0, 1, At, B1); PG8_BAR;
            PG8_LDA(At, 1, 1); PG8_STAGE(PG8_SA(1, 0), a3, voffA);
            PG8_BAR; PG8_WAIT_L(0); PG8_MMA(1, 0, At, B0); PG8_BAR; PG8_SCHED;
            PG8_STAGE(PG8_SB(1, 1), b3 + hstep, voffB);
            PG8_WAIT_V(6); PG8_BAR; PG8_MMA(1, 1, At, B1); PG8_BAR;
            }
        }
        if constexpr (ALIGN_EPI) { if (wr == 0) PG8_BAR; }
        if constexpr (!Epi::AFTER_DRAIN) { E(acc, cur, wr, wc, fr, fq); S.done(cur); }
        if (!has_next) break;
#pragma unroll
        for (int a = 0; a < 2; ++a)
#pragma unroll
            for (int b = 0; b < 2; ++b)
#pragma unroll
                for (int m = 0; m < 4; ++m)
#pragma unroll
                    for (int n = 0; n < 2; ++n) acc[a][b][m][n] = (f32x4){0.f, 0.f, 0.f, 0.f};
        cur = nxt; cA = nA; cB = nB; ++ui;
        if constexpr (ALIGN_EPI) { if (wr == 1) PG8_BAR; }
    }
    PG8_WAIT_V(0);
    if constexpr (!ALIGN_EPI) { if (wr == 0) PG8_BAR; }
    PG8_BAR;
    if constexpr (Epi::AFTER_DRAIN) { E.fused(acc, cur, wr, wc, fr, fq, lds, wid, lane); S.done(cur); }
#undef PG8_SA
#undef PG8_SB
#undef PG8_STAGE
#undef PG8_LDA
#undef PG8_LDB
#undef PG8_MMA
#undef PG8_WAIT_V
#undef PG8_WAIT_L
#undef PG8_BAR
#undef PG8_SCHED
}
}

#ifndef PG8_SP2
#define PG8_SP2 true
#endif
#define GAS __attribute__((address_space(1)))
#define LAS __attribute__((address_space(3)))
typedef unsigned short bf16;
typedef unsigned v4u __attribute__((ext_vector_type(4)));
typedef float f32x4 __attribute__((ext_vector_type(4)));
typedef short bf16x8 __attribute__((ext_vector_type(8)));
typedef GAS unsigned gu32;
typedef GAS unsigned long long gu64;
#define RLX_AGENT __ATOMIC_RELAXED, __HIP_MEMORY_SCOPE_AGENT
#define LDS_WAIT() asm volatile("s_waitcnt lgkmcnt(0)" ::: "memory")
#define VM_WAIT() asm volatile("s_waitcnt vmcnt(0)" ::: "memory")
__device__ __forceinline__ unsigned long long rt() { return __builtin_amdgcn_s_memrealtime(); }
__device__ __forceinline__ unsigned f2bf(float f) { unsigned u = __builtin_bit_cast(unsigned, f); return (u + 0x7fffu + ((u >> 16) & 1u)) >> 16; }
__device__ __forceinline__ unsigned pk2(float lo, float hi) { return f2bf(lo) | (f2bf(hi) << 16); }
#define XB_TMO      128
#define XB_XCNT(j)  (256  + 64 * (j))
#define XB_XSUB(j)  (1280 + 64 * (j))
#define XB_XGEN(j)  (2304 + 64 * (j))
#define XB_TOP      3328
#define XB_TOPGEN   3392
#define XCD_BAR_WORDS 3456
#define XB_SPIN_CAP (1u << 18)

__device__ __forceinline__ unsigned xb_ld(unsigned* p)              { return __hip_atomic_load(p, __ATOMIC_RELAXED, __HIP_MEMORY_SCOPE_AGENT); }
__device__ __forceinline__ unsigned xb_add(unsigned* p, unsigned v) { return __hip_atomic_fetch_add(p, v, __ATOMIC_RELAXED, __HIP_MEMORY_SCOPE_AGENT); }
__device__ __forceinline__ unsigned xb_xcc_id() { return (unsigned)__builtin_amdgcn_s_getreg((3 << 11) | 20) & 0xFu; }
#define XB_SPIN(cond, bar) do { unsigned _sp = 0; while (cond) { __builtin_amdgcn_s_sleep(1); \
    if ((++_sp & 255u) == 0u) { if (xb_ld(&(bar)[XB_TMO])) break; if (_sp > XB_SPIN_CAP) { atomicAdd(&(bar)[XB_TMO], 1u); break; } } } } while (0)

struct XcdBarrier {
    unsigned* bar; unsigned x;
    volatile LAS unsigned* st;
};

__device__ __forceinline__ XcdBarrier xcd_barrier_post(unsigned* bar, volatile LAS unsigned* st) {
    XcdBarrier b; b.bar = bar; b.x = xb_xcc_id(); b.st = st;
    if (threadIdx.x == 0) (void)xb_add(&bar[XB_XCNT(b.x)], 1u);
    return b;
}
__device__ __forceinline__ void xcd_barrier_complete(unsigned* bar, unsigned x, unsigned& nloc, unsigned& nx) {
    const unsigned G = gridDim.x * gridDim.y * gridDim.z;
    unsigned sum, cnt, mine, sp = 0u;
    for (;;) {
        sum = 0u; cnt = 0u; mine = 0u;
#pragma unroll
        for (unsigned j = 0; j < 16; ++j) { const unsigned c = xb_ld(&bar[XB_XCNT(j)]); sum += c; cnt += (c > 0u) ? 1u : 0u; mine = (j == x) ? c : mine; }
        if (sum == G) break;
        __builtin_amdgcn_s_sleep(1);
        if ((++sp & 255u) == 0u) { if (xb_ld(&bar[XB_TMO])) break; if (sp > XB_SPIN_CAP) { atomicAdd(&bar[XB_TMO], 1u); break; } }
    }
    nloc = mine > 0u ? mine : 1u; nx = cnt > 0u ? cnt : 1u;
}

__device__ __forceinline__ void xcd_barrier(const XcdBarrier& b) {
    asm volatile("s_waitcnt vmcnt(0)" ::: "memory");
    __syncthreads();
    if (threadIdx.x == 0) {
        unsigned* bar = b.bar;
        __builtin_amdgcn_s_waitcnt(0);
        unsigned nloc = b.st[0], nx = b.st[1];
        if (nloc == 0u) { xcd_barrier_complete(bar, b.x, nloc, nx); b.st[0] = nloc; b.st[1] = nx; }
        const unsigned old = xb_add(&bar[XB_XSUB(b.x)], 1u);
        const unsigned gen = old / nloc;
        if (old + 1u == (gen + 1u) * nloc) {
            __builtin_amdgcn_fence(__ATOMIC_RELEASE, "agent");
            asm volatile("s_waitcnt vmcnt(0)" ::: "memory");
            const unsigned og = xb_add(&bar[XB_TOP], 1u);
            const unsigned tg = og / nx;
            if (og + 1u == (tg + 1u) * nx) xb_add(&bar[XB_TOPGEN], 1u);
            else XB_SPIN(xb_ld(&bar[XB_TOPGEN]) == tg, bar);
            __builtin_amdgcn_fence(__ATOMIC_ACQUIRE, "agent");
            xb_add(&bar[XB_XGEN(b.x)], 1u);
            asm volatile("s_waitcnt vmcnt(0)" ::: "memory");
        } else {
            XB_SPIN(xb_ld(&bar[XB_XGEN(b.x)]) == gen, bar);
            __builtin_amdgcn_fence(__ATOMIC_ACQUIRE, "agent");
            asm volatile("s_waitcnt vmcnt(0)" ::: "memory");
        }
    }
    __syncthreads();
}

constexpr int NWAVES = 8, NTHREADS = 512;
constexpr int RING_BYTES = 131072, LDSCTL_OFF = RING_BYTES, MISC_OFF = LDSCTL_OFF + 320, LDS_BYTES = 147456;

struct Args { const float* x; const int* pos; const float *ln_g, *w_in, *qn_g, *w_q_b, *kvn_g, *w_kv_b, *hg_lb, *hg_ng, *w_out, *fn_g; float* out; unsigned char* ws; int ph_lo, ph_hi; };

__device__ __forceinline__ float wave_sum(float v) {
#pragma unroll
    for (int o = 1; o < 64; o <<= 1) v += __shfl_xor(v, o);
    return v;
}
__device__ __forceinline__ int tid_opaque() { int t = threadIdx.x; asm volatile("" : "+v"(t)); return t; }
__device__ __forceinline__ float bf2f(bf16 b) { return __builtin_bit_cast(float, (unsigned)b << 16); }

__device__ const double INV_FREQ[16] = {1.0, 0.5623413251903491, 0.31622776601683794, 0.1778279410038923, 0.1, 0.05623413251903491, 0.03162277660168379, 0.01778279410038923,
                                        0.01, 0.005623413251903491, 0.0031622776601683794, 0.0017782794100389228, 0.001, 0.0005623413251903491, 0.00031622776601683794, 0.00017782794100389227};
__device__ __forceinline__ void p0_transpose_item(const float* W, int ldw, const float* kscale, bf16* WT, int ldt, int k0, int src_n0, int dst_n0, LAS float* scr, int lane) {
#pragma unroll 8
    for (int i = 0; i < 32; ++i) { const int kk = 2 * i + (lane >> 5); float v = 0.f;
        if (src_n0 >= 0) { v = W[(size_t)(k0 + kk) * ldw + src_n0 + (lane & 31)]; if (kscale) v *= kscale[k0 + kk]; }
        scr[kk * 33 + (lane & 31)] = v; }
    LDS_WAIT(); asm volatile("" ::: "memory");
    const int c = lane & 7;
#pragma unroll
    for (int j = 0; j < 4; ++j) { const int n = (lane >> 3) + 8 * j; const LAS float* s = scr + (8 * c) * 33 + n;
        v4u o; o.x = pk2(s[0 * 33], s[1 * 33]); o.y = pk2(s[2 * 33], s[3 * 33]); o.z = pk2(s[4 * 33], s[5 * 33]); o.w = pk2(s[6 * 33], s[7 * 33]);
        *(GAS v4u*)(WT + (size_t)(dst_n0 + n) * ldt + k0 + 8 * c) = o; }
    LDS_WAIT(); asm volatile("" ::: "memory");
}
__device__ __forceinline__ int w1_src_col(int n0) {
    if (n0 < 416) return n0;
    if (n0 < 512) return -1;
    if (n0 < 1024) return C_GMLA + (n0 - 512);
    if (n0 < 2048) { const int h = (n0 - 1024) >> 8, w = (n0 - 1024) & 255; return w < 128 ? C_HQ + 128 * h + w : C_HF + 128 * h + (w - 128); }
    if (n0 < 2560) return C_HI + (n0 - 2048);
    return C_GHG + (n0 - 2560);
}
__device__ __forceinline__ void p0_prologue(const Args& a, LAS unsigned char* lds, int vcu, int G) {
    const int tid = tid_opaque(), lane = tid & 63, wave = __builtin_amdgcn_readfirstlane(tid >> 6);
    unsigned char* ws = a.ws;
    LAS float* scr = (LAS float*)(lds + wave * 16384);
    const int gw = vcu * NWAVES + wave, NGW = G * NWAVES;
    constexpr int I_1 = (DMODEL / 64) * (N1 / 32), I_Q = (QRANK / 64) * (NQ / 32), I_KV = (KVRANK / 64) * (NKV / 32), I_O = (DMODEL / 64) * (DMODEL / 32);
    for (int it = gw; it < I_1 + I_Q + I_KV + I_O; it += NGW) {
        int r = it;
        if (r < I_1) { const int nb = r % (N1 / 32), kb = r / (N1 / 32); p0_transpose_item(a.w_in, D_IN, nullptr, (bf16*)(ws + WS_W1T), DMODEL, 64 * kb, w1_src_col(32 * nb), 32 * nb, scr, lane); continue; } r -= I_1;
        if (r < I_Q) { const int nb = r % (NQ / 32), kb = r / (NQ / 32); p0_transpose_item(a.w_q_b, NQ, a.qn_g, (bf16*)(ws + WS_WQT), QRANK, 64 * kb, 32 * nb, 32 * nb, scr, lane); continue; } r -= I_Q;
        if (r < I_KV) { const int nb = r % (NKV / 32), kb = r / (NKV / 32); p0_transpose_item(a.w_kv_b, NKV, a.kvn_g, (bf16*)(ws + WS_WKVT), KVRANK, 64 * kb, 32 * nb, 32 * nb, scr, lane); continue; } r -= I_KV;
        { const int nb = r % (DMODEL / 32), kb = r / (DMODEL / 32); p0_transpose_item(a.w_out, DMODEL, nullptr, (bf16*)(ws + WS_WOT), DMODEL, 64 * kb, 32 * nb, 32 * nb, scr, lane); }
    }
    f32x4 gv[4];
#pragma unroll
    for (int j = 0; j < 4; ++j) gv[j] = *((const f32x4*)a.ln_g + lane + 64 * j);
    for (int m = gw; m < MTOK; m += NGW) {
        const GAS f32x4* xr = (const GAS f32x4*)(a.x + (size_t)m * DMODEL) + lane;
        f32x4 v[4]; float s = 0.f;
#pragma unroll
        for (int j = 0; j < 4; ++j) { v[j] = xr[64 * j]; s += (v[j].x * v[j].x + v[j].y * v[j].y) + (v[j].z * v[j].z + v[j].w * v[j].w); }
        const float rstd = rsqrtf(wave_sum(s) * (1.f / DMODEL) + EPS);
        GAS unsigned long long* o8 = (GAS unsigned long long*)((bf16*)(ws + WS_XN) + (size_t)m * DMODEL) + lane;
#pragma unroll
        for (int j = 0; j < 4; ++j) { const f32x4 y = v[j] * rstd * gv[j]; o8[64 * j] = (unsigned long long)pk2(y.x, y.y) | ((unsigned long long)pk2(y.z, y.w) << 32); }
    }
    { const int gt = vcu * NTHREADS + wave * 64 + lane, NGT = G * NTHREADS;
      float2* cs = (float2*)(ws + WS_CS);
      for (int e = gt; e < MTOK * 16; e += NGT) { const int m = e >> 4, i = e & 15;
          double r = (double)a.pos[m] * INV_FREQ[i] * 0.15915494309189535; r -= floor(r);
          const float rf = (float)r; cs[e] = make_float2(__builtin_amdgcn_cosf(rf), __builtin_amdgcn_sinf(rf)); }
      if (gt < HGW) { const float a0 = a.hg_lb[gt], a1 = a.hg_lb[HGW + gt]; ((float*)(ws + WS_LB))[gt] = 1.f / (1.f + expf(a1 - a0)); }
    }
}

__device__ __forceinline__ void naive_attn_unit(int unit, const Args& a, LAS unsigned char* lds) {
    const int tid = tid_opaque();
    unsigned char* ws = a.ws;
    const bf16* Q = (const bf16*)(ws + WS_Q); const bf16* KN = (const bf16*)(ws + WS_KN); const bf16* KPE = (const bf16*)(ws + WS_KPE); const bf16* V = (const bf16*)(ws + WS_V);
    const bf16* GM = (const bf16*)(ws + WS_GMLA); bf16* Y = (bf16*)(ws + WS_Y);
    const int qb = unit & 7, h = (unit >> 3) & 7, b = unit >> 6;
    LAS float* Ks = (LAS float*)lds; LAS float* Vs = Ks + 64 * QHD;
    const int qrow = qb * 512 + tid; const size_t grow = (size_t)b * SEQ + qrow;
    float q[QHD], o[VDIM];
#pragma unroll
    for (int d = 0; d < QHD; ++d) q[d] = bf2f(Q[grow * NQ + h * QHD + d]);
#pragma unroll
    for (int d = 0; d < VDIM; ++d) o[d] = 0.f;
    float mx = -1e30f, l = 0.f;
    const int nt = (qb * 512 + 512) / 64;
    for (int j = 0; j < nt; ++j) {
        __syncthreads();
        for (int idx = tid; idx < 64 * QHD; idx += NTHREADS) { const int key = idx / QHD, d = idx % QHD; const size_t kr = (size_t)b * SEQ + 64 * j + key;
            Ks[idx] = d < NOPE ? bf2f(KN[kr * 512 + h * NOPE + d]) : bf2f(KPE[kr * ROPE + (d - NOPE)]); }
        for (int idx = tid; idx < 64 * VDIM; idx += NTHREADS) { const int key = idx / VDIM, d = idx % VDIM; Vs[idx] = bf2f(V[((size_t)b * SEQ + 64 * j + key) * 512 + h * VDIM + d]); }
        __syncthreads();
        for (int key = 0; key < 64; ++key) {
            if (64 * j + key <= qrow) {
                float s = 0.f;
#pragma unroll
                for (int d = 0; d < QHD; ++d) s += q[d] * Ks[key * QHD + d];
                if (s > mx) { const float al = exp2f(mx - s); l *= al;
#pragma unroll
                    for (int d = 0; d < VDIM; ++d) o[d] *= al;
                    mx = s; }
                const float p = exp2f(s - mx); l += p;
#pragma unroll
                for (int d = 0; d < VDIM; ++d) o[d] += p * Vs[key * VDIM + d];
            }
        }
    }
    const float rl = 1.f / l;
#pragma unroll
    for (int d = 0; d < VDIM; d += 2) { const float y0 = o[d] * rl * bf2f(GM[grow * 512 + h * VDIM + d]), y1 = o[d + 1] * rl * bf2f(GM[grow * 512 + h * VDIM + d + 1]);
        *(unsigned*)(Y + grow * DMODEL + h * VDIM + d) = pk2(y0, y1); }
    __syncthreads();
}
__device__ __forceinline__ void naive_scan_unit(int unit, const Args& a, LAS unsigned char* lds) {
    const int tid = tid_opaque();
    unsigned char* ws = a.ws;
    const bf16* QG = (const bf16*)(ws + WS_QG); const bf16* KG = (const bf16*)(ws + WS_KG); const bf16* HV = (const bf16*)(ws + WS_HV);
    const float* ER = (const float*)(ws + WS_ER); const float* EER = (const float*)(ws + WS_EER); float* OS = (float*)(ws + WS_OS);
    const int h = unit & 3, b = unit >> 2;
    LAS float* kgs = (LAS float*)lds; LAS float* qgs = kgs + 128; LAS float* vs = qgs + 128; LAS float* part = vs + 128; LAS float* ers = part + 512; LAS float* eers = ers + 128;
    const int v = tid & 127, kq = tid >> 7;
    float S[32];
#pragma unroll
    for (int i = 0; i < 32; ++i) S[i] = 0.f;
    for (int c = 0; c < NCHUNK; ++c) {
        const size_t gch = (size_t)b * NCHUNK + c;
        __syncthreads();
        if (tid < 128) ers[tid] = ER[gch * HGW + h * HGD + tid]; else if (tid < 256) eers[tid - 128] = EER[gch * HGW + h * HGD + tid - 128];
        __syncthreads();
#pragma unroll
        for (int i = 0; i < 32; ++i) S[i] *= ers[kq * 32 + i];
        for (int t = 0; t < CHUNK; ++t) {
            const size_t row = (size_t)b * SEQ + c * CHUNK + t;
            if (tid < 128) kgs[tid] = bf2f(KG[row * HGW + h * HGD + tid]); else if (tid < 256) qgs[tid - 128] = bf2f(QG[row * HGW + h * HGD + tid - 128]); else if (tid < 384) vs[tid - 256] = bf2f(HV[row * HGW + h * HGD + tid - 256]);
            __syncthreads();
            const float vv = vs[v]; float po = 0.f;
#pragma unroll
            for (int i = 0; i < 32; ++i) { S[i] += kgs[kq * 32 + i] * vv; po += S[i] * qgs[kq * 32 + i]; }
            part[kq * 128 + v] = po;
            __syncthreads();
            if (tid < 128) OS[row * HGW + h * HGD + tid] = (part[tid] + part[128 + tid]) + (part[256 + tid] + part[384 + tid]);
        }
#pragma unroll
        for (int i = 0; i < 32; ++i) S[i] *= eers[kq * 32 + i];
    }
    __syncthreads();
}
__device__ __forceinline__ void scan_norm_phase(const Args& a, int vcu, int G) {
    const int tid = tid_opaque(), lane = tid & 63, wave = __builtin_amdgcn_readfirstlane(tid >> 6);
    unsigned char* ws = a.ws; const float* OS = (const float*)(ws + WS_OS); const bf16* GH = (const bf16*)(ws + WS_GHG); bf16* Y = (bf16*)(ws + WS_Y);
    const int gw = vcu * NWAVES + wave, NGW = G * NWAVES;
    for (int idx = gw; idx < MTOK * HGH; idx += NGW) { const size_t row = idx >> 2; const int h = idx & 3, c = h * HGD + 2 * lane;
        const float2 o = *(const float2*)(OS + row * HGW + c); const float rstd = rsqrtf(wave_sum(o.x * o.x + o.y * o.y) * (1.f / HGD) + EPS);
        const unsigned gg = *(const unsigned*)(GH + row * HGW + c);
        const float y0 = o.x * rstd * a.hg_ng[c] * bf2f((bf16)(gg & 0xffffu)), y1 = o.y * rstd * a.hg_ng[c + 1] * bf2f((bf16)(gg >> 16));
        *(unsigned*)(Y + row * DMODEL + MLAW + c) = pk2(y0, y1); }
}
__device__ __forceinline__ void final_norm_phase(const Args& a, int vcu, int G) {
    const int tid = tid_opaque(), lane = tid & 63, wave = __builtin_amdgcn_readfirstlane(tid >> 6);
    const float* SSQO = (const float*)(a.ws + WS_SSQO);
    const int gw = vcu * NWAVES + wave, NGW = G * NWAVES;
    f32x4 gv[4];
#pragma unroll
    for (int j = 0; j < 4; ++j) gv[j] = *((const f32x4*)a.fn_g + lane + 64 * j);
    for (int m = gw; m < MTOK; m += NGW) {
        float s = (lane < 16) ? SSQO[(size_t)m * 16 + lane] : 0.f; s = wave_sum(s);
        const float rstd = rsqrtf(s * (1.f / DMODEL) + EPS);
        GAS f32x4* orow = (GAS f32x4*)(a.out + (size_t)m * DMODEL) + lane;
#pragma unroll
        for (int j = 0; j < 4; ++j) { const f32x4 v = orow[64 * j]; orow[64 * j] = v * rstd * gv[j]; }
    }
}

namespace at {
typedef short bf16x8 __attribute__((ext_vector_type(8)));
typedef short s16x4 __attribute__((ext_vector_type(4)));
typedef short v4i16_t __attribute__((ext_vector_type(4)));
typedef float f32x16 __attribute__((ext_vector_type(16)));
typedef float f32x4 __attribute__((ext_vector_type(4)));
typedef unsigned u32x4 __attribute__((ext_vector_type(4)));
typedef LAS const char* lcp;
constexpr int QB = 256, KVBLK = 64, KROW = 208  , KBUF = 64 * KROW, VBUF = 64 * 128;
constexpr int L_K = 0, L_V = 2 * KBUF, L_WS = L_V + 2 * VBUF, L_OST = L_WS + 8 * 256, L_END = L_OST + 8 * 8192;
constexpr float THR = 8.f;
#define SBAR() __builtin_amdgcn_sched_barrier(0)
#define MFMA32(a, b, c) __builtin_amdgcn_mfma_f32_32x32x16_bf16(a, b, c, 0, 0, 0)
__device__ __forceinline__ int crow(int r, int hi) { return (r & 3) + 8 * (r >> 2) + 4 * hi; }
__device__ __forceinline__ unsigned cvtpk(float lo, float hi) { unsigned r; asm volatile("v_cvt_pk_bf16_f32 %0, %1, %2" : "=v"(r) : "v"(lo), "v"(hi)); return r; }
__device__ __forceinline__ s16x4 vtr(lcp p) { return __builtin_bit_cast(s16x4, __builtin_amdgcn_ds_read_tr16_b64_v4i16((LAS v4i16_t*)p)); }
__device__ __forceinline__ void mask_tile(f32x16& p0, f32x16& p1, int dq) {
    const float NEG = -__builtin_inff();
#pragma unroll
    for (int r = 0; r < 16; ++r) { const int c = (r & 3) + 8 * (r >> 2); if (dq - c < 0) p0[r] = NEG; if (dq - c - 32 < 0) p1[r] = NEG; }
}
__device__ __forceinline__ void partialSM(f32x16& p0, f32x16& p1, float& m_reg, float& alpha) {
    float pmax = p0[0];
#pragma unroll
    for (int r = 1; r < 16; ++r) pmax = fmaxf(pmax, p0[r]);
#pragma unroll
    for (int r = 0; r < 16; ++r) pmax = fmaxf(pmax, p1[r]);
    { auto rr = __builtin_amdgcn_permlane32_swap(__float_as_uint(pmax), __float_as_uint(pmax), false, false); pmax = fmaxf(__uint_as_float(rr[0]), __uint_as_float(rr[1])); }
    float mn;
    if (__builtin_expect(__all(pmax - m_reg <= THR), 1)) { mn = m_reg; alpha = 1.f; }
    else { mn = fmaxf(m_reg, pmax); alpha = __builtin_amdgcn_exp2f(m_reg - mn); m_reg = mn; }
#pragma unroll
    for (int r = 0; r < 16; ++r) { p0[r] -= mn; p1[r] -= mn; }
#pragma unroll
    for (int r = 0; r < 16; ++r) p0[r] = __builtin_amdgcn_exp2f(p0[r]);
}
__device__ __forceinline__ void finishSM(f32x16& p0, f32x16& p1, float alpha, float& l_reg, bf16x8& pa0, bf16x8& pa1, bf16x8& pa2, bf16x8& pa3) {
#pragma unroll
    for (int r = 0; r < 16; ++r) p1[r] = __builtin_amdgcn_exp2f(p1[r]);
    float ps = 0.f;
#pragma unroll
    for (int r = 0; r < 16; ++r) ps += p0[r];
#pragma unroll
    for (int r = 0; r < 16; ++r) ps += p1[r];
    { auto rr = __builtin_amdgcn_permlane32_swap(__float_as_uint(ps), __float_as_uint(ps), false, false); ps = __uint_as_float(rr[0]) + __uint_as_float(rr[1]); }
    l_reg = l_reg * alpha + ps;
#define PK4(P, B_, OUT) do { unsigned a0 = cvtpk(P[B_+0], P[B_+1]), a1 = cvtpk(P[B_+2], P[B_+3]); unsigned b0 = cvtpk(P[B_+4], P[B_+5]), b1 = cvtpk(P[B_+6], P[B_+7]); \
        auto r0 = __builtin_amdgcn_permlane32_swap(a0, b0, false, false); auto r1 = __builtin_amdgcn_permlane32_swap(a1, b1, false, false); \
        u32x4 w = {r0[0], r1[0], r0[1], r1[1]}; OUT = __builtin_bit_cast(bf16x8, w); } while (0)
    PK4(p0, 0, pa0); PK4(p0, 8, pa1); PK4(p1, 0, pa2); PK4(p1, 8, pa3);
#undef PK4
}
template <int KB> __device__ __forceinline__ void qkt(f32x16& p0, f32x16& p1, lcp kp, const bf16x8* qr) {
    p0 = f32x16{}; p1 = f32x16{};
    lcp a = kp + KB * KBUF;
#pragma unroll
    for (int d0 = 0; d0 < 6; ++d0) {
        const bf16x8 b0 = *(const LAS bf16x8*)(a + d0 * 32);
        const bf16x8 b1 = *(const LAS bf16x8*)(a + d0 * 32 + 32 * KROW);
        p0 = MFMA32(b0, qr[d0], p0); p1 = MFMA32(b1, qr[d0], p1);
    }
}
template <int VB> __device__ __forceinline__ void pv_tile(f32x16* o, lcp vp, bf16x8 pa0, bf16x8 pa1, bf16x8 pa2, bf16x8 pa3) {
    lcp a = vp + VB * VBUF;
#pragma unroll
    for (int d0 = 0; d0 < 2; ++d0) {
        s16x4 l0 = vtr(a + d0 * 512), h0 = vtr(a + d0 * 512 + 256), l1 = vtr(a + 2048 + d0 * 512), h1 = vtr(a + 2048 + d0 * 512 + 256);
        s16x4 l2 = vtr(a + 4096 + d0 * 512), h2 = vtr(a + 4096 + d0 * 512 + 256), l3 = vtr(a + 6144 + d0 * 512), h3 = vtr(a + 6144 + d0 * 512 + 256);
        o[d0] = MFMA32(pa0, ((bf16x8){l0[0], l0[1], l0[2], l0[3], h0[0], h0[1], h0[2], h0[3]}), o[d0]);
        o[d0] = MFMA32(pa1, ((bf16x8){l1[0], l1[1], l1[2], l1[3], h1[0], h1[1], h1[2], h1[3]}), o[d0]);
        o[d0] = MFMA32(pa2, ((bf16x8){l2[0], l2[1], l2[2], l2[3], h2[0], h2[1], h2[2], h2[3]}), o[d0]);
        o[d0] = MFMA32(pa3, ((bf16x8){l3[0], l3[1], l3[2], l3[3], h3[0], h3[1], h3[2], h3[3]}), o[d0]);
    }
}

__device__ __forceinline__ void attn_unit(int b, int h, int qb, unsigned char* ws, LAS unsigned char* lds) {
    const int tid = tid_opaque(), lane = tid & 63, r32 = lane & 31, hi = lane >> 5; const int wid = __builtin_amdgcn_readfirstlane(tid >> 6);
    const bf16* Q = (const bf16*)(ws + WS_Q); const bf16* KN = (const bf16*)(ws + WS_KN); const bf16* KPE = (const bf16*)(ws + WS_KPE); const bf16* V = (const bf16*)(ws + WS_V);
    const bf16* GM = (const bf16*)(ws + WS_GMLA); bf16* Y = (bf16*)(ws + WS_Y);
    const size_t rowbase = (size_t)b * SEQ; const int q0 = qb * QB, NT = (q0 + QB) / KVBLK;
    const int skey = tid >> 3, sch = tid & 7, pkey = (tid >> 2) & 63, pch = tid & 3; const bool pe = wid < 4;
    const bf16* kn_src = KN + (rowbase + skey) * 512 + h * NOPE + sch * 8; const bf16* v_src = V + (rowbase + skey) * 512 + h * VDIM + sch * 8;
    const bf16* kp_src = KPE + (rowbase + pkey) * ROPE + pch * 8;
    LAS unsigned char* kn_dst = lds + L_K + skey * KROW + sch * 16; LAS unsigned char* kp_dst = lds + L_K + pkey * KROW + 128 + pch * 16;
    LAS unsigned char* v_dst = lds + L_V + ((skey >> 3) * 2 + (sch >> 2)) * 512 + (skey & 7) * 64 + (sch & 3) * 16;
    bf16x8 st_kn, st_kp, st_v;
#define SLOAD(t) do { st_kn = *(const bf16x8*)(kn_src + (size_t)(t) * KVBLK * 512); st_v = *(const bf16x8*)(v_src + (size_t)(t) * KVBLK * 512); if (pe) st_kp = *(const bf16x8*)(kp_src + (size_t)(t) * KVBLK * ROPE); } while (0)
#define SWRITE(bf) do { *(LAS bf16x8*)(kn_dst + (bf) * KBUF) = st_kn; *(LAS bf16x8*)(v_dst + (bf) * VBUF) = st_v; if (pe) *(LAS bf16x8*)(kp_dst + (bf) * KBUF) = st_kp; } while (0)
    lcp kp = (lcp)lds + L_K + r32 * KROW + hi * 16;
    lcp vp = (lcp)lds + L_V + hi * 1024 + ((lane >> 2) & 3) * 64 + ((lane >> 4) & 1) * 32 + (lane & 3) * 8;
    LAS float* wsf = (LAS float*)(lds + L_WS) + wid * 64; LAS float* li_l = wsf; LAS float* al_l = wsf + 32;
    bf16x8 qr[6];
    { const bf16* qw = Q + (rowbase + q0 + wid * 32 + r32) * NQ + h * QHD + hi * 8;
#pragma unroll
      for (int d0 = 0; d0 < 6; ++d0) qr[d0] = *(const bf16x8*)(qw + d0 * 16); }
    const int qlo = q0 + wid * 32, qm = qlo + r32 - 4 * hi;
    float m_reg = -1e30f, l_reg = 0.f; f32x16 o[2]; o[0] = f32x16{}; o[1] = f32x16{};
#define MASKT(P0_, P1_, t) do { const int kb_ = (t) * KVBLK; if (kb_ + KVBLK - 1 > qlo) mask_tile(P0_, P1_, qm - kb_); } while (0)
#define RESC(a_) do { if (__any((a_) < 1.f)) { if (hi == 0) al_l[r32] = (a_); \
        _Pragma("unroll") for (int d_ = 0; d_ < 2; ++d_) _Pragma("unroll") for (int r = 0; r < 16; ++r) o[d_][r] *= al_l[crow(r, hi)]; } } while (0)
    f32x16 pA0, pA1, pB0, pB1; float alA, alB; bf16x8 pa0, pa1, pa2, pa3;
    __syncthreads();
    SLOAD(0); SWRITE(0); SLOAD(1);
    __syncthreads();
    qkt<0>(pA0, pA1, kp, qr); MASKT(pA0, pA1, 0); partialSM(pA0, pA1, m_reg, alA);
    SWRITE(1);
    __syncthreads();
#define HALF_STEP(PX0, PX1, alX, PY0, PY1, alY, t, KB, VB) do { \
        SBAR(); qkt<KB>(PX0, PX1, kp, qr); \
        finishSM(PY0, PY1, alY, l_reg, pa0, pa1, pa2, pa3); SBAR(); \
        if ((t) + 1 < NT) { SLOAD((t) + 1); } SBAR(); \
        pv_tile<VB>(o, vp, pa0, pa1, pa2, pa3); MASKT(PX0, PX1, (t)); partialSM(PX0, PX1, m_reg, alX); \
        __syncthreads(); \
        if ((t) + 1 < NT) { SWRITE(VB); } \
        RESC(alX); __syncthreads(); } while (0)
    for (int t = 1; t + 1 < NT; t += 2) {
        HALF_STEP(pB0, pB1, alB, pA0, pA1, alA, t, 1, 0);
        HALF_STEP(pA0, pA1, alA, pB0, pB1, alB, t + 1, 0, 1);
    }
    SBAR(); qkt<1>(pB0, pB1, kp, qr);
    finishSM(pA0, pA1, alA, l_reg, pa0, pa1, pa2, pa3); SBAR();
    pv_tile<0>(o, vp, pa0, pa1, pa2, pa3);
    MASKT(pB0, pB1, NT - 1); partialSM(pB0, pB1, m_reg, alB); RESC(alB);
    finishSM(pB0, pB1, alB, l_reg, pa0, pa1, pa2, pa3); SBAR();
    pv_tile<1>(o, vp, pa0, pa1, pa2, pa3);
    if (hi == 0) li_l[r32] = l_reg;
    LAS float* stg = (LAS float*)(lds + L_OST) + wid * 2048;
#pragma unroll
    for (int r = 0; r < 16; ++r) { const int orow = crow(r, hi); const float rl = __builtin_amdgcn_rcpf(li_l[orow]);
#pragma unroll
        for (int d0 = 0; d0 < 2; ++d0) stg[orow * 64 + d0 * 32 + r32] = o[d0][r] * rl; }
#pragma unroll
    for (int i = 0; i < 4; ++i) { const int row = i * 8 + (lane >> 3), ch = lane & 7; const size_t grow = rowbase + q0 + wid * 32 + row;
        const f32x4 x0 = *(const LAS f32x4*)(stg + row * 64 + ch * 8), x1 = *(const LAS f32x4*)(stg + row * 64 + ch * 8 + 4);
        const u32x4 g = *(const u32x4*)(GM + grow * 512 + h * VDIM + ch * 8);
        u32x4 w;
        w.x = cvtpk(x0[0] * __uint_as_float(g.x << 16), x0[1] * __uint_as_float(g.x & 0xffff0000u)); w.y = cvtpk(x0[2] * __uint_as_float(g.y << 16), x0[3] * __uint_as_float(g.y & 0xffff0000u));
        w.z = cvtpk(x1[0] * __uint_as_float(g.z << 16), x1[1] * __uint_as_float(g.z & 0xffff0000u)); w.w = cvtpk(x1[2] * __uint_as_float(g.w << 16), x1[3] * __uint_as_float(g.w & 0xffff0000u));
        *(u32x4*)(Y + grow * DMODEL + h * VDIM + ch * 8) = w; }
#undef SLOAD
#undef SWRITE
#undef MASKT
#undef RESC
#undef HALF_STEP
}
#undef SBAR
#undef MFMA32
}

namespace sc {
typedef short bf16x8 __attribute__((ext_vector_type(8)));
typedef short s16x4 __attribute__((ext_vector_type(4)));
typedef short v4i16_t __attribute__((ext_vector_type(4)));
typedef float f32x16 __attribute__((ext_vector_type(16)));
typedef float f32x4 __attribute__((ext_vector_type(4)));
typedef unsigned u32x4 __attribute__((ext_vector_type(4)));
typedef unsigned u32x2 __attribute__((ext_vector_type(2)));
typedef LAS const char* lcp;
constexpr int TILE = 16384;
constexpr int L_T = 0, L_S = 6 * TILE;
constexpr int L_ER = RING_BYTES + 1024, L_SSQ = L_ER + 2048;
static_assert(L_S + 2 * TILE == RING_BYTES && L_SSQ + 1024 <= LDS_BYTES, "scan LDS map");
#define MFMA32(a, b, c) __builtin_amdgcn_mfma_f32_32x32x16_bf16(a, b, c, 0, 0, 0)
__device__ __forceinline__ unsigned off_a(unsigned row, unsigned ch) { return 2048u * (row >> 3) + 512u * (ch >> 2) + 64u * (row & 7) + 16u * ((ch & 3) ^ ((row >> 2) & 3)); }
__device__ __forceinline__ unsigned cvtpk(float lo, float hi) { unsigned r; asm volatile("v_cvt_pk_bf16_f32 %0, %1, %2" : "=v"(r) : "v"(lo), "v"(hi)); return r; }
__device__ __forceinline__ s16x4 vtr(lcp p) { return __builtin_bit_cast(s16x4, __builtin_amdgcn_ds_read_tr16_b64_v4i16((LAS v4i16_t*)p)); }
__device__ __forceinline__ bf16x8 cat8(s16x4 l, s16x4 h) { return (bf16x8){l[0], l[1], l[2], l[3], h[0], h[1], h[2], h[3]}; }
__device__ __forceinline__ void pack2(const f32x16& p, bf16x8& f0, bf16x8& f1) {
#define PK4(B_, OUT) do { unsigned a0 = cvtpk(p[B_+0], p[B_+1]), a1 = cvtpk(p[B_+2], p[B_+3]); unsigned b0 = cvtpk(p[B_+4], p[B_+5]), b1 = cvtpk(p[B_+6], p[B_+7]); \
        auto r0 = __builtin_amdgcn_permlane32_swap(a0, b0, false, false); auto r1 = __builtin_amdgcn_permlane32_swap(a1, b1, false, false); \
        u32x4 w = {r0[0], r1[0], r0[1], r1[1]}; OUT = __builtin_bit_cast(bf16x8, w); } while (0)
    PK4(0, f0); PK4(8, f1);
#undef PK4
}

__device__ __forceinline__ void scan_unit(int unit, const Args& a, LAS unsigned char* lds) {
    unsigned char* ws = a.ws;
    const int tid = tid_opaque(), lane = tid & 63, l31 = lane & 31, hi = lane >> 5; const int wid = __builtin_amdgcn_readfirstlane(tid >> 6);
    const int th = wid >> 2, vb = wid & 3, h = unit & 3, b = unit >> 2;
    const bf16* QG = (const bf16*)(ws + WS_QG) + h * HGD; const bf16* KG = (const bf16*)(ws + WS_KG) + h * HGD; const bf16* HV = (const bf16*)(ws + WS_HV) + h * HGD;
    const bf16* GH = (const bf16*)(ws + WS_GHG) + h * HGD; bf16* Y = (bf16*)(ws + WS_Y) + MLAW + h * HGD;
    const float* ER = (const float*)(ws + WS_ER) + h * HGD; const float* EER = (const float*)(ws + WS_EER) + h * HGD;
    const size_t rowbase = (size_t)b * SEQ;
    const int srow = tid >> 4, sch = tid & 15; const unsigned sdst = off_a(srow, sch);
    const size_t ssrc = (rowbase + srow) * HGW + sch * 8;
    bf16x8 st[6]; float st_e = 0.f;
#define SLOAD(c) do { const size_t o_ = ssrc + (size_t)(c) * CHUNK * HGW; \
        st[0] = *(const bf16x8*)(QG + o_); st[1] = *(const bf16x8*)(QG + o_ + 32 * HGW); st[2] = *(const bf16x8*)(KG + o_); st[3] = *(const bf16x8*)(KG + o_ + 32 * HGW); \
        st[4] = *(const bf16x8*)(HV + o_); st[5] = *(const bf16x8*)(HV + o_ + 32 * HGW); \
        if (wid < 2) st_e = ER[((size_t)b * NCHUNK + (c)) * HGW + tid]; else if (wid < 4) st_e = EER[((size_t)b * NCHUNK + (c)) * HGW + tid - 128]; } while (0)
#define SWRITE(bf) do { LAS unsigned char* d_ = lds + L_T + (bf) * 3 * TILE + sdst; \
        *(LAS bf16x8*)(d_) = st[0]; *(LAS bf16x8*)(d_ + 8192) = st[1]; *(LAS bf16x8*)(d_ + TILE) = st[2]; *(LAS bf16x8*)(d_ + TILE + 8192) = st[3]; \
        *(LAS bf16x8*)(d_ + 2 * TILE) = st[4]; *(LAS bf16x8*)(d_ + 2 * TILE + 8192) = st[5]; \
        if (wid < 4) ((LAS float*)(lds + L_ER))[(bf) * 256 + tid] = st_e; } while (0)
    const unsigned x = (l31 >> 2) & 3;
    const unsigned rb_e = 2048u * (l31 >> 3) + 64u * (l31 & 7) + 16u * ((unsigned)hi ^ x), rb_o = 2048u * (l31 >> 3) + 64u * (l31 & 7) + 16u * ((2u + hi) ^ x);
    const unsigned q4 = (lane & 15) >> 2, p4 = lane & 3, blk = (lane >> 4) & 1;
    const unsigned tb0 = 2048u * hi + 64u * q4 + 16u * ((2u * blk + (p4 >> 1)) ^ (2u * hi)) + 8u * (p4 & 1);
    const unsigned tb1 = 2048u * hi + 64u * (4u + q4) + 16u * ((2u * blk + (p4 >> 1)) ^ (2u * hi + 1u)) + 8u * (p4 & 1);
    const unsigned wbase = 8192u * vb + 2048u * (l31 >> 3) + 64u * (l31 & 7) + 8u * hi;
    LAS float* ssq_l = (LAS float*)(lds + L_SSQ);
    f32x4 ng[4];
#pragma unroll
    for (int g = 0; g < 4; ++g) ng[g] = *(const f32x4*)(a.hg_ng + h * HGD + 32 * vb + 8 * g + 4 * hi);
    f32x16 S0 = f32x16{}, S1 = f32x16{};
    __syncthreads();
    SLOAD(0); SWRITE(0);
    __syncthreads();
    for (int c = 0; c < NCHUNK; ++c) {
        const int bf = c & 1;
        lcp tQ = (lcp)lds + L_T + bf * 3 * TILE, tK = tQ + TILE, tV = tQ + 2 * TILE; lcp tS = (lcp)lds + L_S;
        const LAS float* er = (const LAS float*)(lds + L_ER) + bf * 256; const LAS float* eer = er + 128;
#pragma unroll
        for (int g = 0; g < 4; ++g) { const f32x4 e0 = *(const LAS f32x4*)(er + 64 * th + 8 * g + 4 * hi), e1 = *(const LAS f32x4*)(er + 64 * th + 32 + 8 * g + 4 * hi);
#pragma unroll
            for (int e = 0; e < 4; ++e) { S0[4 * g + e] *= e0[e]; S1[4 * g + e] *= e1[e]; }
            u32x2 w0, w1; w0.x = cvtpk(S0[4 * g], S0[4 * g + 1]); w0.y = cvtpk(S0[4 * g + 2], S0[4 * g + 3]); w1.x = cvtpk(S1[4 * g], S1[4 * g + 1]); w1.y = cvtpk(S1[4 * g + 2], S1[4 * g + 3]);
            *(LAS u32x2*)(lds + L_S + wbase + 512u * (2 * th) + 16u * ((unsigned)g ^ x)) = w0; *(LAS u32x2*)(lds + L_S + wbase + 512u * (2 * th + 1) + 16u * ((unsigned)g ^ x)) = w1; }
        __syncthreads();
        if (c + 1 < NCHUNK) SLOAD(c + 1);
        bf16x8 qf[8];
#pragma unroll
        for (int s = 0; s < 8; ++s) qf[s] = *(const LAS bf16x8*)(tQ + 8192 * th + ((s & 1) ? rb_o : rb_e) + 512 * (s >> 1));
        bf16x8 pa[4]; pa[2] = bf16x8{}; pa[3] = bf16x8{};
        {   f32x16 p = f32x16{};
#pragma unroll
            for (int s = 0; s < 8; ++s) p = MFMA32(*(const LAS bf16x8*)(tK + ((s & 1) ? rb_o : rb_e) + 512 * (s >> 1)), qf[s], p);
            if (th == 0) {
#pragma unroll
                for (int r = 0; r < 16; ++r) if (((r & 3) + 8 * (r >> 2) + 4 * hi) > l31) p[r] = 0.f; }
            pack2(p, pa[0], pa[1]); }
        if (th == 1) { f32x16 p = f32x16{};
#pragma unroll
            for (int s = 0; s < 8; ++s) p = MFMA32(*(const LAS bf16x8*)(tK + 8192 + ((s & 1) ? rb_o : rb_e) + 512 * (s >> 1)), qf[s], p);
#pragma unroll
            for (int r = 0; r < 16; ++r) if (((r & 3) + 8 * (r >> 2) + 4 * hi) > l31) p[r] = 0.f;
            pack2(p, pa[2], pa[3]); }
        bf16x8 vf[4];
#pragma unroll
        for (int ks = 0; ks < 4; ++ks) vf[ks] = cat8(vtr(tV + tb0 + 4096 * ks + 512 * vb), vtr(tV + tb1 + 4096 * ks + 512 * vb));
        f32x16 o = f32x16{};
        o = MFMA32(vf[0], pa[0], o); o = MFMA32(vf[1], pa[1], o);
        if (th == 1) { o = MFMA32(vf[2], pa[2], o); o = MFMA32(vf[3], pa[3], o); }
#pragma unroll
        for (int s = 0; s < 8; ++s) o = MFMA32(*(const LAS bf16x8*)(tS + 8192 * vb + ((s & 1) ? rb_o : rb_e) + 512 * (s >> 1)), qf[s], o);
#pragma unroll
        for (int ks = 0; ks < 4; ++ks) {
            S0 = MFMA32(cat8(vtr(tK + tb0 + 4096 * ks + 512 * (2 * th)), vtr(tK + tb1 + 4096 * ks + 512 * (2 * th))), vf[ks], S0);
            S1 = MFMA32(cat8(vtr(tK + tb0 + 4096 * ks + 512 * (2 * th + 1)), vtr(tK + tb1 + 4096 * ks + 512 * (2 * th + 1))), vf[ks], S1); }
#pragma unroll
        for (int g = 0; g < 4; ++g) { const f32x4 e0 = *(const LAS f32x4*)(eer + 64 * th + 8 * g + 4 * hi), e1 = *(const LAS f32x4*)(eer + 64 * th + 32 + 8 * g + 4 * hi);
#pragma unroll
            for (int e = 0; e < 4; ++e) { S0[4 * g + e] *= e0[e]; S1[4 * g + e] *= e1[e]; } }
        float ss = 0.f;
#pragma unroll
        for (int r = 0; r < 16; ++r) ss += o[r] * o[r];
        { auto rr = __builtin_amdgcn_permlane32_swap(__float_as_uint(ss), __float_as_uint(ss), false, false); ss = __uint_as_float(rr[0]) + __uint_as_float(rr[1]); }
        if (hi == 0) ssq_l[(th * 4 + vb) * 32 + l31] = ss;
        if (c + 1 < NCHUNK) SWRITE(bf ^ 1);
        __syncthreads();
        const float tot = (ssq_l[(th * 4 + 0) * 32 + l31] + ssq_l[(th * 4 + 1) * 32 + l31]) + (ssq_l[(th * 4 + 2) * 32 + l31] + ssq_l[(th * 4 + 3) * 32 + l31]);
        const float rstd = rsqrtf(tot * (1.f / HGD) + EPS);
        const size_t grow = rowbase + (size_t)c * CHUNK + 32 * th + l31;
#pragma unroll
        for (int g = 0; g < 4; ++g) { const int col = 32 * vb + 8 * g + 4 * hi;
            const u32x2 gg = *(const u32x2*)(GH + grow * HGW + col);
            u32x2 w; w.x = cvtpk(o[4 * g] * rstd * ng[g][0] * __uint_as_float(gg.x << 16), o[4 * g + 1] * rstd * ng[g][1] * __uint_as_float(gg.x & 0xffff0000u));
            w.y = cvtpk(o[4 * g + 2] * rstd * ng[g][2] * __uint_as_float(gg.y << 16), o[4 * g + 3] * rstd * ng[g][3] * __uint_as_float(gg.y & 0xffff0000u));
            *(u32x2*)(Y + grow * DMODEL + col) = w; }
    }
#undef SLOAD
#undef SWRITE
}
#undef MFMA32
}

#ifndef MK_PER_PHASE
#define MK_PER_PHASE 0
#endif
#ifndef NAIVE_ATTN
#define NAIVE_ATTN 0
#endif
#ifndef NAIVE_SCAN
#define NAIVE_SCAN 0
#endif
#if NAIVE_SCAN
#define SCAN_UNIT(u) naive_scan_unit((u), a, lds)
#else
#define SCAN_UNIT(u) sc::scan_unit((u), a, lds)
#endif
constexpr int N_PHASES = 7;
__global__ void __launch_bounds__(NTHREADS, 2) hyb_fwd(Args a) {
    extern __shared__ __attribute__((aligned(16))) unsigned char lds_raw[];
    LAS unsigned char* lds = (LAS unsigned char*)lds_raw;
    const int G = gridDim.x; const int bx = blockIdx.x; const int vcu = (G % 8 == 0) ? (bx % 8) * (G / 8) + bx / 8 : bx;
    unsigned char* ws = a.ws;
    gu32* ctl = (gu32*)(ws + WS_CTL);
    volatile LAS unsigned* MISC = (volatile LAS unsigned*)(lds + MISC_OFF);
    for (int u = threadIdx.x; u < (LDS_BYTES - LDSCTL_OFF) / 4; u += NTHREADS) ((LAS unsigned*)(lds + LDSCTL_OFF))[u] = 0u;
    __syncthreads();
    const int lo = a.ph_lo, hi = a.ph_hi;
    const bool fusedl = (hi - lo) > 1;
    XcdBarrier bar; bar.bar = (unsigned*)(ctl + CW_BAR); bar.x = 0; bar.st = nullptr;
    if (fusedl) bar = xcd_barrier_post((unsigned*)(ctl + CW_BAR), MISC + 8);
#define IN(k) (lo <= (k) && (k) < hi)
#define SEAM(k) do { if (IN(k) && IN((k) + 1)) xcd_barrier(bar); } while (0)

#ifndef NO_P0
    if (IN(0)) { p0_prologue(a, lds, vcu, G); SEAM(0); }
#endif

#ifndef NO_P1
    if (IN(1)) {
        pg8::Gemm g{(const bf16*)(ws + WS_XN), (const bf16*)(ws + WS_W1T), MTOK, N1, DMODEL}; pg8::StaticOrder S; S.init(MTOK, N1, G, bx);
        pg8::EpiP1 E{ws};
        pg8::gemm_phase<pg8::EpiP1, pg8::StaticOrder, true, PG8_SP2>(lds, g, S, E);
        SEAM(1);
    }
#endif
#ifndef NO_P2
    if (IN(2)) {
        { pg8::Gemm g{(const bf16*)(ws + WS_QLAT), (const bf16*)(ws + WS_WQT), MTOK, NQ, QRANK}; pg8::StaticOrder S; S.init(MTOK, NQ, G, bx);
          pg8::EpiQ E{(bf16*)(ws + WS_Q), (const float*)(ws + WS_SSQQ), (const pg8::f32x2e*)(ws + WS_CS)};
          pg8::gemm_phase<pg8::EpiQ, pg8::StaticOrder, true, PG8_SP2>(lds, g, S, E); }
        { pg8::Gemm g{(const bf16*)(ws + WS_KVLAT), (const bf16*)(ws + WS_WKVT), MTOK, NKV, KVRANK}; pg8::StaticOrder S; S.init(MTOK, NKV, G, bx);
          pg8::EpiKV E{(bf16*)(ws + WS_KN), (bf16*)(ws + WS_V), (const float*)(ws + WS_SSQKV)};
          pg8::gemm_phase<pg8::EpiKV, pg8::StaticOrder, true, PG8_SP2>(lds, g, S, E); }
        SEAM(2);
    }
#endif
#ifndef NO_P3
    if (IN(3)) {
#if NAIVE_ATTN
        if (bx < BATCH * HGH) naive_scan_unit(bx, a, lds);
        for (int u = bx; u < BATCH * NHEAD * (SEQ / 512); u += G) naive_attn_unit(u, a, lds);
#else
        const unsigned xq = xb_xcc_id() & 7u;
        for (unsigned qi = 0; qi < 8; ++qi) { const unsigned q = (xq + qi) & 7u;
            for (;;) {
                __syncthreads();
                if (threadIdx.x == 0) MISC[16] = __hip_atomic_fetch_add(ctl + CW_QUEUE + 64 * q, 1u, __ATOMIC_RELAXED, __HIP_MEMORY_SCOPE_AGENT);
                __syncthreads();
                const unsigned k = MISC[16];
                if (k >= 4 + 128) break;
                if (k < 4) SCAN_UNIT((int)(q * 4 + k));
                else { const unsigned k2 = k - 4, bh = q * 8 + (k2 & 7); at::attn_unit((int)(bh >> 3), (int)(bh & 7), 15 - (int)(k2 >> 3), ws, lds); }
            }
        }
#endif
#if NAIVE_SCAN
        SEAM(3);
#else
        if (IN(3) && IN(5)) xcd_barrier(bar);
#endif
    }
#endif
#if NAIVE_SCAN
    if (IN(4)) { scan_norm_phase(a, vcu, G); SEAM(4); }
#endif
#ifndef NO_P5
    if (IN(5)) {
        pg8::Gemm g{(const bf16*)(ws + WS_Y), (const bf16*)(ws + WS_WOT), MTOK, DMODEL, DMODEL}; pg8::StaticOrder S; S.init(MTOK, DMODEL, G, bx);
        pg8::EpiOut E{a.x, a.out, (float*)(ws + WS_SSQO)};
        pg8::gemm_phase<pg8::EpiOut, pg8::StaticOrder, true, PG8_SP2>(lds, g, S, E);
        SEAM(5);
    }
#endif
    if (IN(6)) final_norm_phase(a, vcu, G);
#undef IN
#undef SEAM
}

extern "C" void kernel_launch(void* const* d_in, const int* in_sizes, int n_in, void* d_out, int out_size, void* d_ws, size_t ws_size, hipStream_t stream) {
    static int grid = 0;
    if (grid == 0) {
        if (n_in != 12 || in_sizes[0] != MTOK * DMODEL || out_size != MTOK * DMODEL || ws_size < WS_END) { fprintf(stderr, "kernel_launch: unexpected shapes (n_in %d, in0 %d, out %d, ws %zu); nothing launched\n", n_in, n_in > 0 ? in_sizes[0] : -1, out_size, ws_size); grid = -1; return; }
        int dev = 0, cus = 0, per_cu = 0;
        if (hipGetDevice(&dev) != hipSuccess || hipDeviceGetAttribute(&cus, hipDeviceAttributeMultiprocessorCount, dev) != hipSuccess) { fprintf(stderr, "kernel_launch: device query failed\n"); grid = -1; return; }
        if (hipFuncSetAttribute((const void*)hyb_fwd, hipFuncAttributeMaxDynamicSharedMemorySize, LDS_BYTES) != hipSuccess) { fprintf(stderr, "kernel_launch: hipFuncSetAttribute failed\n"); grid = -1; return; }
        if (hipOccupancyMaxActiveBlocksPerMultiprocessor(&per_cu, (const void*)hyb_fwd, NTHREADS, LDS_BYTES) != hipSuccess || per_cu < 1) { fprintf(stderr, "kernel_launch: occupancy query reports %d workgroups per CU\n", per_cu); per_cu = 1; }
        (void)hipGetLastError();
        grid = cus;
    }
    if (grid < 0) return;
    if (hipMemsetAsync((char*)d_ws + WS_CTL, 0, CTL_ZERO_BYTES, stream) != hipSuccess) { fprintf(stderr, "kernel_launch: hipMemsetAsync failed\n"); return; }
    Args a{};
    a.x = (const float*)d_in[0]; a.pos = (const int*)d_in[1]; a.ln_g = (const float*)d_in[2]; a.w_in = (const float*)d_in[3]; a.qn_g = (const float*)d_in[4]; a.w_q_b = (const float*)d_in[5];
    a.kvn_g = (const float*)d_in[6]; a.w_kv_b = (const float*)d_in[7]; a.hg_lb = (const float*)d_in[8]; a.hg_ng = (const float*)d_in[9]; a.w_out = (const float*)d_in[10]; a.fn_g = (const float*)d_in[11];
    a.out = (float*)d_out; a.ws = (unsigned char*)d_ws;
#if MK_PER_PHASE
    for (int p = 0; p < N_PHASES; ++p) { a.ph_lo = p; a.ph_hi = p + 1; hipLaunchKernelGGL(hyb_fwd, dim3(grid), dim3(NTHREADS), LDS_BYTES, stream, a); }
#else
    a.ph_lo = 0; a.ph_hi = N_PHASES; hipLaunchKernelGGL(hyb_fwd, dim3(grid), dim3(NTHREADS), LDS_BYTES, stream, a);
#endif
    const hipError_t le = hipPeekAtLastError();
    if (le != hipSuccess) fprintf(stderr, "kernel_launch: launch failed: %s\n", hipGetErrorName(le));
}
```

```cpp
#include <hip/hip_runtime.h>
#include <hip/hip_bf16.h>
#include <cstdio>
#include <cstdint>

constexpr int BATCH = 8, SEQ = 4096, DMODEL = 1024, MTOK = BATCH * SEQ;
constexpr int D_IN = 2976, N1 = 3072;
constexpr int NHEAD = 8, NOPE = 64, ROPE = 32, VDIM = 64, QRANK = 256, KVRANK = 128, QHD = NOPE + ROPE;
constexpr int NQ = NHEAD * QHD  , NKV = NHEAD * (NOPE + VDIM)  , MLAW = NHEAD * VDIM  ;
constexpr int HGH = 4, HGD = 128, HGW = 512, CHUNK = 64, NCHUNK = SEQ / CHUNK;
constexpr float EPS = 1e-6f;
constexpr float QSCALE = 0.1472444460259031f;
constexpr int C_QLAT = 0, C_KVLAT = 256, C_KROPE = 384, C_GMLA = 416, C_HQ = 928, C_HF = 1440, C_HI = 1952, C_GHG = 2464;

constexpr size_t MiB = 1u << 20;
constexpr size_t WS_CTL = 0, CTL_ZERO_BYTES = 64 * 1024;
constexpr size_t WS_W1T = 2 * MiB;
constexpr size_t WS_WQT = 8 * MiB;
constexpr size_t WS_WKVT = 8 * MiB + 512 * 1024;
constexpr size_t WS_WOT = 9 * MiB;
constexpr size_t WS_CS = 11 * MiB;
constexpr size_t WS_LB = 15 * MiB;
constexpr size_t WS_SSQQ = 16 * MiB, WS_SSQKV = 16 * MiB + 512 * 1024;
constexpr size_t WS_SSQO = 17 * MiB;
constexpr size_t WS_ER = 19 * MiB, WS_EER = 20 * MiB;
constexpr size_t WS_XN = 32 * MiB;
constexpr size_t WS_Y = 32 * MiB;
constexpr size_t WS_QLAT = 96 * MiB, WS_KVLAT = 112 * MiB, WS_KPE = 120 * MiB;
constexpr size_t WS_GMLA = 128 * MiB, WS_QG = 160 * MiB, WS_KG = 192 * MiB, WS_HV = 224 * MiB, WS_GHG = 256 * MiB;
constexpr size_t WS_Q = 288 * MiB;
constexpr size_t WS_KN = 336 * MiB, WS_V = 368 * MiB;
constexpr size_t WS_OS = 400 * MiB;
constexpr size_t WS_END = 464 * MiB;
constexpr int CW_BAR = 1024;
constexpr int CW_QUEUE = 8192;
static_assert((CW_BAR + 3456) * 4 <= (int)CTL_ZERO_BYTES && (CW_QUEUE + 64 * 16) * 4 <= (int)CTL_ZERO_BYTES, "CTL words inside the memset region");

namespace pg8 {
#define PG8_LAS __attribute__((address_space(3)))
typedef unsigned short bf16_t;
typedef short bf16x8 __attribute__((ext_vector_type(8)));
typedef float f32x4 __attribute__((ext_vector_type(4)));
typedef unsigned u32x4 __attribute__((ext_vector_type(4)));
constexpr int BM = 256, BK = 64, HALF = 128, HTB = HALF * BK * 2  , STAGE_BYTES = 8 * HTB, NXCD = 8, WGM = 8;

__host__ __device__ __forceinline__ int lds_byte(int r, int c) { const int st = (r >> 4) * 2 + (c >> 5), rr = r & 15, cc = c & 31, ob = rr * 64 + cc * 2; return st * 1024 + (ob ^ (((ob >> 9) & 1) << 5)); }
__host__ __device__ __forceinline__ void stage_rc(int b, int& R, int& C) { const int st = b / 1024, sb = b % 1024, swz = sb ^ (((sb >> 9) & 1) << 5); R = (st >> 1) * 16 + swz / 64; C = (st & 1) * 32 + (swz % 64) / 2; }
__host__ __device__ __forceinline__ int perm32(int rho) { const int n = rho >> 4, i = rho & 15; return 8 * (i >> 2) + 4 * n + (i & 3); }

struct Unit { int pm, pn; };
struct Gemm { const bf16_t* A; const bf16_t* Bt; int M, N, K; };

struct StaticOrder {
    int nM, nN, nwg, G, c;
    __host__ __device__ void init(int M, int N, int G_, int c_) { nM = M / BM; nN = N / BM; nwg = nM * nN; G = G_; c = c_; }
    __host__ __device__ bool next(int i, Unit& u) const {
        const long L = (long)i * G + c; if (L >= nwg) return false;
        int wgid = (int)L; { const int q = nwg / NXCD, r = nwg % NXCD, xcd = wgid % NXCD, off = wgid / NXCD; wgid = (xcd < r ? xcd * (q + 1) : r * (q + 1) + (xcd - r) * q) + off; }
        const int nig = WGM * nN, gid = wgid / nig, fm = gid * WGM, gsz = (nM - fm) < WGM ? (nM - fm) : WGM;
        u.pm = fm + ((wgid % nig) % gsz); u.pn = (wgid % nig) / gsz; return true;
    }
    __device__ __forceinline__ void a_ready(const Unit&) const {}
    __device__ __forceinline__ void done(const Unit&) const {}
};

__device__ __forceinline__ unsigned cvt_pk_bf16(float lo, float hi) { unsigned r; asm volatile("v_cvt_pk_bf16_f32 %0, %1, %2" : "=v"(r) : "v"(lo), "v"(hi)); return r; }
typedef float f32x2e __attribute__((ext_vector_type(2)));
__device__ __forceinline__ void st8(bf16_t* p, const f32x4& a, const f32x4& b) {
    u32x4 w; w.x = cvt_pk_bf16(a[0], a[1]); w.y = cvt_pk_bf16(a[2], a[3]); w.z = cvt_pk_bf16(b[0], b[1]); w.w = cvt_pk_bf16(b[2], b[3]);
    *(u32x4*)p = w;
}
__device__ __forceinline__ float sigm(float x) { return __builtin_amdgcn_rcpf(1.0f + __expf(-x)); }
__device__ __forceinline__ float silu_f(float x) { return x * sigm(x); }
__device__ __forceinline__ f32x4 silu4(const f32x4& v) { f32x4 o; o[0] = silu_f(v[0]); o[1] = silu_f(v[1]); o[2] = silu_f(v[2]); o[3] = silu_f(v[3]); return o; }
__device__ __forceinline__ float sq4(const f32x4& v) { return (v[0] * v[0] + v[1] * v[1]) + (v[2] * v[2] + v[3] * v[3]); }
template <int SH> __device__ __forceinline__ float dpp_shr(float v) {
    return __builtin_bit_cast(float, __builtin_amdgcn_update_dpp(0, __builtin_bit_cast(int, v), 0x110 + SH, 0xf, 0xf, true));
}
__device__ __forceinline__ float scan16(float v) { v += dpp_shr<1>(v); v += dpp_shr<2>(v); v += dpp_shr<4>(v); v += dpp_shr<8>(v); return v; }
__device__ __forceinline__ float clampe(float x) { return fminf(fmaxf(x, -80.f), 80.f); }

struct EpiP1 {
    static constexpr bool PERM = true, AFTER_DRAIN = false;
    unsigned char* ws; const float* NG;
    __device__ __forceinline__ void operator()(const f32x4 (&acc)[2][2][4][2], const Unit& u, int wr, int wc, int fr, int fq) const {
        { int t_ = threadIdx.x; asm volatile("" : "+v"(t_)); fr = t_ & 15; fq = (t_ >> 4) & 3; }
        const int pn = u.pn, lane = fq * 16 + fr;
        bf16_t* const QLAT = (bf16_t*)(ws + WS_QLAT); bf16_t* const KVLAT = (bf16_t*)(ws + WS_KVLAT); bf16_t* const KPE = (bf16_t*)(ws + WS_KPE);
        bf16_t* const QG = (bf16_t*)(ws + WS_QG); bf16_t* const KG = (bf16_t*)(ws + WS_KG);
        float* const SSQQ = (float*)(ws + WS_SSQQ); float* const SSQKV = (float*)(ws + WS_SSQKV); float* const ER = (float*)(ws + WS_ER); float* const EER = (float*)(ws + WS_EER);
        const float* const LB = (const float*)(ws + WS_LB); const f32x2e* const CS = (const f32x2e*)(ws + WS_CS);
        const int rowb = u.pm * BM + wr * 64 + fr, cw = wc * 32 + 8 * fq;
        if (pn == 0) {
#pragma unroll
            for (int ai = 0; ai < 2; ++ai)
#pragma unroll
                for (int m = 0; m < 4; ++m) { const size_t row = (size_t)(rowb + ai * HALF + m * 16); float s = 0.f;
#pragma unroll
                    for (int bj = 0; bj < 2; ++bj) { const f32x4 v0 = acc[ai][bj][m][0], v1 = acc[ai][bj][m][1]; s += sq4(v0) + sq4(v1); st8(QLAT + row * QRANK + bj * HALF + cw, v0, v1); }
                    s += __shfl_xor(s, 16); s += __shfl_xor(s, 32); if (fq == 0) SSQQ[row * 4 + wc] = s; }
        } else if (pn == 1) {
#pragma unroll
            for (int ai = 0; ai < 2; ++ai)
#pragma unroll
                for (int m = 0; m < 4; ++m) { const size_t row = (size_t)(rowb + ai * HALF + m * 16);
                    const f32x4 v0 = acc[ai][0][m][0], v1 = acc[ai][0][m][1]; float s = sq4(v0) + sq4(v1); st8(KVLAT + row * KVRANK + cw, v0, v1);
                    s += __shfl_xor(s, 16); s += __shfl_xor(s, 32); if (fq == 0) SSQKV[row * 4 + wc] = s;
                    if (wc == 0) {
                        const f32x4 x0 = acc[ai][1][m][0], x1 = acc[ai][1][m][1]; f32x4 p0, p1, o0, o1;
#pragma unroll
                        for (int j = 0; j < 4; ++j) { p0[j] = __shfl_xor(x0[j], 32); p1[j] = __shfl_xor(x1[j], 32); }
                        const f32x2e* cs = CS + row * 16 + 8 * (fq & 1); const float sg = (fq < 2) ? -1.f : 1.f;
#pragma unroll
                        for (int j = 0; j < 4; ++j) { const f32x2e c0 = cs[j], c1 = cs[4 + j]; o0[j] = x0[j] * c0.x + sg * p0[j] * c0.y; o1[j] = x1[j] * c1.x + sg * p1[j] * c1.y; }
                        st8(KPE + row * ROPE + 8 * fq, o0, o1);
                    } }
        } else if (pn < 4 || pn >= 8) {
            size_t doff; bool act; int colt;
            if (pn < 4) { doff = WS_GMLA; act = true; colt = (pn - 2) * BM; } else if (pn < 10) { doff = WS_HV; act = false; colt = (pn - 8) * BM; } else { doff = WS_GHG; act = true; colt = (pn - 10) * BM; }
            bf16_t* const dst = (bf16_t*)(ws + doff);
#pragma unroll
            for (int ai = 0; ai < 2; ++ai)
#pragma unroll
                for (int m = 0; m < 4; ++m) { const size_t row = (size_t)(rowb + ai * HALF + m * 16);
#pragma unroll
                    for (int bj = 0; bj < 2; ++bj) { f32x4 v0 = acc[ai][bj][m][0], v1 = acc[ai][bj][m][1]; if (act) { v0 = silu4(v0); v1 = silu4(v1); }
                        if (pn >= 10) { v0 = v0 * *(const f32x4*)(NG + colt + bj * HALF + cw); v1 = v1 * *(const f32x4*)(NG + colt + bj * HALF + cw + 4); }
                        st8(dst + row * 512 + colt + bj * HALF + cw, v0, v1); } }
        } else {
            const int ch0 = (pn - 4) * HGD + cw;
#pragma unroll
            for (int ai = 0; ai < 2; ++ai) {
                const int gch = (u.pm * BM + ai * HALF + wr * 64) >> 6;
                f32x4 qo[4][2], ko[4][2];
#pragma unroll
                for (int n = 0; n < 2; ++n)
#pragma unroll
                    for (int j = 0; j < 4; ++j) { const float lb = LB[ch0 + 4 * n + j], oml = 1.f - lb;
                        float g[4], kk[4];
#pragma unroll
                        for (int m = 0; m < 4; ++m) { const float x = acc[ai][1][m][n][j]; const float f = lb + oml * sigm(x); kk[m] = oml * sigm(-x); g[m] = scan16(__logf(f)); }
                        const int l15 = (lane & 48) | 15;
                        const float t0 = __shfl(g[0], l15), t1 = __shfl(g[1], l15), t2 = __shfl(g[2], l15), t3 = __shfl(g[3], l15);
                        g[1] += t0; g[2] += t0 + t1; g[3] += (t0 + t1) + t2;
                        const float R = t0 + t1, Gend = (t0 + t1) + (t2 + t3);
#pragma unroll
                        for (int m = 0; m < 4; ++m) { const float d = clampe(g[m] - R); qo[m][n][j] = silu_f(acc[ai][0][m][n][j]) * __expf(d); ko[m][n][j] = kk[m] * __expf(-d); }
                        if (fr == 15) { ER[(size_t)gch * HGW + ch0 + 4 * n + j] = __expf(clampe(R)); EER[(size_t)gch * HGW + ch0 + 4 * n + j] = __expf(clampe(Gend - R)); }
                    }
#pragma unroll
                for (int m = 0; m < 4; ++m) { const size_t row = (size_t)(rowb + ai * HALF + m * 16); st8(QG + row * HGW + ch0, qo[m][0], qo[m][1]); st8(KG + row * HGW + ch0, ko[m][0], ko[m][1]); }
            }
        }
    }
};

struct EpiQ {
    static constexpr bool PERM = true, AFTER_DRAIN = false;
    bf16_t* Q; const float* SSQQ; const f32x2e* CS;
    __device__ __forceinline__ void operator()(const f32x4 (&acc)[2][2][4][2], const Unit& u, int wr, int wc, int fr, int fq) const {
        { int t_ = threadIdx.x; asm volatile("" : "+v"(t_)); fr = t_ & 15; fq = (t_ >> 4) & 3; }
        const int rowb = u.pm * BM + wr * 64 + fr;
#pragma unroll
        for (int ai = 0; ai < 2; ++ai)
#pragma unroll
            for (int m = 0; m < 4; ++m) { const size_t row = (size_t)(rowb + ai * HALF + m * 16);
                const f32x4 sq = *(const f32x4*)(SSQQ + row * 4); const float rs = rsqrtf(((sq[0] + sq[1]) + (sq[2] + sq[3])) * (1.f / QRANK) + EPS) * QSCALE;
#pragma unroll
                for (int bj = 0; bj < 2; ++bj) { const int g32 = u.pn * 8 + bj * 4 + wc;
                    f32x4 x0 = acc[ai][bj][m][0] * rs, x1 = acc[ai][bj][m][1] * rs;
                    if (g32 % 3 == 2) {
                        f32x4 p0, p1, o0, o1;
#pragma unroll
                        for (int j = 0; j < 4; ++j) { p0[j] = __shfl_xor(x0[j], 32); p1[j] = __shfl_xor(x1[j], 32); }
                        const f32x2e* cs = CS + row * 16 + 8 * (fq & 1); const float sg = (fq < 2) ? -1.f : 1.f;
#pragma unroll
                        for (int j = 0; j < 4; ++j) { const f32x2e c0 = cs[j], c1 = cs[4 + j]; o0[j] = x0[j] * c0.x + sg * p0[j] * c0.y; o1[j] = x1[j] * c1.x + sg * p1[j] * c1.y; }
                        x0 = o0; x1 = o1;
                    }
                    st8(Q + row * NQ + g32 * 32 + 8 * fq, x0, x1); } }
    }
};
struct EpiKV {
    static constexpr bool PERM = true, AFTER_DRAIN = false;
    bf16_t *KN, *V; const float* SSQKV;
    __device__ __forceinline__ void operator()(const f32x4 (&acc)[2][2][4][2], const Unit& u, int wr, int wc, int fr, int fq) const {
        { int t_ = threadIdx.x; asm volatile("" : "+v"(t_)); fr = t_ & 15; fq = (t_ >> 4) & 3; }
        const int rowb = u.pm * BM + wr * 64 + fr;
#pragma unroll
        for (int ai = 0; ai < 2; ++ai)
#pragma unroll
            for (int m = 0; m < 4; ++m) { const size_t row = (size_t)(rowb + ai * HALF + m * 16);
                const f32x4 sq = *(const f32x4*)(SSQKV + row * 4); const float rs = rsqrtf(((sq[0] + sq[1]) + (sq[2] + sq[3])) * (1.f / KVRANK) + EPS);
#pragma unroll
                for (int bj = 0; bj < 2; ++bj) { const int g32 = u.pn * 8 + bj * 4 + wc, h = g32 >> 2, part = g32 & 3;
                    bf16_t* dst = (part < 2 ? KN : V) + row * 512 + h * 64 + (part & 1) * 32 + 8 * fq;
                    st8(dst, acc[ai][bj][m][0] * rs, acc[ai][bj][m][1] * rs); } }
    }
};
struct EpiOut {
    static constexpr bool PERM = false, AFTER_DRAIN = false;
    const float* X; float* OUT; float* SSQO;
    __device__ __forceinline__ void operator()(const f32x4 (&acc)[2][2][4][2], const Unit& u, int wr, int wc, int fr, int fq) const {
        { int t_ = threadIdx.x; asm volatile("" : "+v"(t_)); fr = t_ & 15; fq = (t_ >> 4) & 3; }
        const int rowb = u.pm * BM + wr * 64 + fr, col0 = u.pn * BM + wc * 32 + 4 * fq;
#pragma unroll
        for (int ai = 0; ai < 2; ++ai)
#pragma unroll
            for (int m = 0; m < 4; ++m) { const size_t off = (size_t)(rowb + ai * HALF + m * 16) * DMODEL + col0; float s = 0.f;
#pragma unroll
                for (int bj = 0; bj < 2; ++bj)
#pragma unroll
                    for (int n = 0; n < 2; ++n) { const f32x4 v = acc[ai][bj][m][n] + *(const f32x4*)(X + off + bj * HALF + n * 16); s += sq4(v); *(f32x4*)(OUT + off + bj * HALF + n * 16) = v; }
                s += __shfl_xor(s, 16); s += __shfl_xor(s, 32); if (fq == 0) SSQO[(size_t)(rowb + ai * HALF + m * 16) * 16 + u.pn * 4 + wc] = s; }
    }
};
template <class Epi, class Sched, bool ALIGN_EPI = false, bool SP2 = false>
__device__ __forceinline__ void gemm_phase(PG8_LAS unsigned char* lds, const Gemm g, const Sched& S, const Epi& E) {
    int tid_ = threadIdx.x; asm volatile("" : "+v"(tid_));
    const int tid = tid_, wid = __builtin_amdgcn_readfirstlane(tid >> 6), lane = tid & 63, wr = wid >> 2, wc = wid & 3, fr = lane & 15, fq = lane >> 4;
    const int K = g.K, nt = K / BK;
    unsigned voffA[2], voffB[2];
#pragma unroll
    for (int i = 0; i < 2; ++i) { int R, C; stage_rc(tid * 16 + i * 8192, R, C); const int Rb = Epi::PERM ? ((R & ~31) + perm32(R & 31)) : R;
        voffA[i] = (unsigned)(R * K + C) * 2u; voffB[i] = (unsigned)(Rb * K + C) * 2u; }
    const size_t kstep = (size_t)(BK * 2);
    const size_t hstep = (size_t)HALF * K * 2;
    const size_t tstep = 2 * hstep;
    const unsigned ldsw = (unsigned)wid * 1024u;
    const int aoff = lds_byte(wr * 64 + fr, fq * 8), boff = lds_byte(wc * 32 + fr, fq * 8);
#define PG8_SA(b, h) (((b) * 2 + (h)) * HTB)
#define PG8_SB(b, h) ((4 + (b) * 2 + (h)) * HTB)
#define PG8_STAGE(bufoff, gbase, voff) do { _Pragma("unroll") for (int _i = 0; _i < 2; ++_i) \
        __builtin_amdgcn_global_load_lds((const unsigned*)((const char*)(gbase) + (voff)[_i]), (PG8_LAS unsigned*)(lds + (bufoff) + ldsw + _i * 8192), 16, 0, 0); } while (0)
#define PG8_LDA(dst, b, h) do { _Pragma("unroll") for (int m = 0; m < 4; ++m) _Pragma("unroll") for (int k = 0; k < 2; ++k) dst[m][k] = *(const PG8_LAS bf16x8*)(lds + PG8_SA(b, h) + aoff + m * 2048 + k * 1024); } while (0)
#define PG8_LDB(dst, b, h) do { _Pragma("unroll") for (int n = 0; n < 2; ++n) _Pragma("unroll") for (int k = 0; k < 2; ++k) dst[n][k] = *(const PG8_LAS bf16x8*)(lds + PG8_SB(b, h) + boff + n * 2048 + k * 1024); } while (0)
#define PG8_MMA(ai, bj, At, Bt) do { __builtin_amdgcn_s_setprio(1); _Pragma("unroll") for (int m = 0; m < 4; ++m) _Pragma("unroll") for (int n = 0; n < 2; ++n) _Pragma("unroll") for (int k = 0; k < 2; ++k) \
        acc[ai][bj][m][n] = __builtin_amdgcn_mfma_f32_16x16x32_bf16(Bt[n][k], At[m][k], acc[ai][bj][m][n], 0, 0, 0); __builtin_amdgcn_s_setprio(0); } while (0)
#define PG8_WAIT_V(n) asm volatile("s_waitcnt vmcnt(" #n ")" ::: "memory")
#define PG8_WAIT_L(n) asm volatile("s_waitcnt lgkmcnt(" #n ")" ::: "memory")
#define PG8_BAR __builtin_amdgcn_s_barrier()
#define PG8_SCHED __builtin_amdgcn_sched_barrier(0)
    Unit cur, nxt; int ui = 0;
    if (!S.next(0, cur)) return;
    f32x4 acc[2][2][4][2];
#pragma unroll
    for (int a = 0; a < 2; ++a)
#pragma unroll
        for (int b = 0; b < 2; ++b)
#pragma unroll
            for (int m = 0; m < 4; ++m)
#pragma unroll
                for (int n = 0; n < 2; ++n) acc[a][b][m][n] = (f32x4){0.f, 0.f, 0.f, 0.f};
    bf16x8 At[4][2], B0[2][2], B1[2][2];
    const char* cA = (const char*)g.A + (size_t)cur.pm * tstep; const char* cB = (const char*)g.Bt + (size_t)cur.pn * tstep;
    S.a_ready(cur);
    if constexpr (SP2) {
        PG8_STAGE(PG8_SB(0, 0), cB, voffB); PG8_STAGE(PG8_SB(0, 1), cB + hstep, voffB); PG8_STAGE(PG8_SA(0, 0), cA, voffA); PG8_STAGE(PG8_SA(0, 1), cA + hstep, voffA);
        if (wr == 1) PG8_BAR;
        PG8_WAIT_V(2); PG8_BAR;
        PG8_STAGE(PG8_SB(1, 0), cB + kstep, voffB); PG8_STAGE(PG8_SA(1, 0), cA + kstep, voffA); PG8_STAGE(PG8_SB(1, 1), cB + hstep + kstep, voffB);
        PG8_WAIT_V(6); PG8_BAR;
    } else {
        PG8_STAGE(PG8_SB(0, 0), cB, voffB); PG8_STAGE(PG8_SA(0, 0), cA, voffA); PG8_STAGE(PG8_SB(0, 1), cB + hstep, voffB); PG8_STAGE(PG8_SA(0, 1), cA + hstep, voffA);
        if (wr == 1) PG8_BAR;
        PG8_WAIT_V(4); PG8_BAR;
        PG8_STAGE(PG8_SB(1, 0), cB + kstep, voffB); PG8_STAGE(PG8_SA(1, 0), cA + kstep, voffA); PG8_STAGE(PG8_SB(1, 1), cB + hstep + kstep, voffB);
        PG8_WAIT_V(6); PG8_BAR;
    }
    for (;;) {
        const bool has_next = S.next(ui + 1, nxt);
        const char* nA = has_next ? (const char*)g.A + (size_t)nxt.pm * tstep : cA; const char* nB = has_next ? (const char*)g.Bt + (size_t)nxt.pn * tstep : cB;
        for (int t = 0; t < nt; t += 2) {
            const bool last = (t == nt - 2);
            const char* a1 = cA + (size_t)(t + 1) * kstep;
            const char* a2 = last ? nA : cA + (size_t)(t + 2) * kstep; const char* b2 = last ? nB : cB + (size_t)(t + 2) * kstep;
            const char* a3 = a2 + kstep; const char* b3 = b2 + kstep;
            if (last && has_next) S.a_ready(nxt);
            if constexpr (SP2) {
            PG8_LDB(B0, 0, 0); PG8_LDB(B1, 0, 1); PG8_SCHED; PG8_LDA(At, 0, 0); PG8_STAGE(PG8_SA(1, 1), a1 + hstep, voffA);
            PG8_WAIT_V(8); PG8_WAIT_L(0); PG8_BAR; PG8_MMA(0, 0, At, B0); PG8_MMA(0, 1, At, B1); PG8_BAR; PG8_SCHED;
            PG8_LDA(At, 0, 1); PG8_STAGE(PG8_SB(0, 0), b2, voffB); PG8_STAGE(PG8_SB(0, 1), b2 + hstep, voffB); PG8_STAGE(PG8_SA(0, 0), a2, voffA);
            PG8_WAIT_V(8); PG8_WAIT_L(0); PG8_BAR; PG8_MMA(1, 0, At, B0); PG8_MMA(1, 1, At, B1); PG8_BAR; PG8_SCHED;
            PG8_LDB(B0, 1, 0); PG8_LDB(B1, 1, 1); PG8_SCHED; PG8_LDA(At, 1, 0); PG8_STAGE(PG8_SA(0, 1), a2 + hstep, voffA);
            PG8_WAIT_V(8); PG8_WAIT_L(0); PG8_BAR; PG8_MMA(0, 0, At, B0); PG8_MMA(0, 1, At, B1); PG8_BAR; PG8_SCHED;
            PG8_LDA(At, 1, 1); PG8_STAGE(PG8_SB(1, 0), b3, voffB); PG8_STAGE(PG8_SB(1, 1), b3 + hstep, voffB); PG8_STAGE(PG8_SA(1, 0), a3, voffA);
            PG8_WAIT_V(8); PG8_WAIT_L(0); PG8_BAR; PG8_MMA(1, 0, At, B0); PG8_MMA(1, 1, At, B1); PG8_BAR; PG8_SCHED;
            } else {
            PG8_LDB(B0, 0, 0); PG8_SCHED; PG8_LDA(At, 0, 0); PG8_STAGE(PG8_SA(1, 1), a1 + hstep, voffA);
            PG8_WAIT_L(8); PG8_BAR; PG8_WAIT_L(0); PG8_MMA(0, 0, At, B0); PG8_BAR; PG8_SCHED;
            PG8_LDB(B1, 0, 1); PG8_STAGE(PG8_SB(0, 0), b2, voffB);
            PG8_BAR; PG8_WAIT_L(0); PG8_MMA(0, 1, At, B1); PG8_BAR;
            PG8_LDA(At, 0, 1); PG8_STAGE(PG8_SA(0, 0), a2, voffA);
            PG8_BAR; PG8_WAIT_L(0); PG8_MMA(1, 0, At, B0); PG8_BAR; PG8_SCHED;
            PG8_STAGE(PG8_SB(0, 1), b2 + hstep, voffB);
            PG8_WAIT_V(6); PG8_BAR; PG8_MMA(1, 1, At, B1); PG8_BAR;
            PG8_LDB(B0, 1, 0); PG8_SCHED; PG8_LDA(At, 1, 0); PG8_STAGE(PG8_SA(0, 1), a2 + hstep, voffA);
            PG8_WAIT_L(8); PG8_BAR; PG8_WAIT_L(0); PG8_MMA(0, 0, At, B0); PG8_BAR; PG8_SCHED;
            PG8_LDB(B1, 1, 1); PG8_STAGE(PG8_SB(1, 0), b3, voffB);
            PG8_BAR; PG8_WAIT_L(0); PG8_MMA(0, 1, At, B1); PG8_BAR;
            PG8_LDA(At, 1, 1); PG8_STAGE(PG8_SA(1, 0), a3, voffA);
            PG8_BAR; PG8_WAIT_L(0); PG8_MMA(1, 0, At, B0); PG8_BAR; PG8_SCHED;
            PG8_STAGE(PG8_SB(1, 1), b3 + hstep, voffB);
            PG8_WAIT_V(6); PG8_BAR; PG8_MMA(1, 1, At, B1); PG8_BAR;
            }
        }
        if constexpr (ALIGN_EPI) { if (wr == 0) PG8_BAR; }
        if constexpr (!Epi::AFTER_DRAIN) { E(acc, cur, wr, wc, fr, fq); S.done(cur); }
        if (!has_next) break;
#pragma unroll
        for (int a = 0; a < 2; ++a)
#pragma unroll
            for (int b = 0; b < 2; ++b)
#pragma unroll
                for (int m = 0; m < 4; ++m)
#pragma unroll
                    for (int n = 0; n < 2; ++n) acc[a][b][m][n] = (f32x4){0.f, 0.f, 0.f, 0.f};
        cur = nxt; cA = nA; cB = nB; ++ui;
        if constexpr (ALIGN_EPI) { if (wr == 1) PG8_BAR; }
    }
    PG8_WAIT_V(0);
    if constexpr (!ALIGN_EPI) { if (wr == 0) PG8_BAR; }
    PG8_BAR;
    if constexpr (Epi::AFTER_DRAIN) { E.fused(acc, cur, wr, wc, fr, fq, lds, wid, lane); S.done(cur); }
#undef PG8_SA
#undef PG8_SB
#undef PG8_STAGE
#undef PG8_LDA
#undef PG8_LDB
#undef PG8_MMA
#undef PG8_WAIT_V
#undef PG8_WAIT_L
#undef PG8_BAR
#undef PG8_SCHED
}
}

#ifndef PG8_SP2
#define PG8_SP2 true
#endif
#define GAS __attribute__((address_space(1)))
#define LAS __attribute__((address_space(3)))
typedef unsigned short bf16;
typedef unsigned v4u __attribute__((ext_vector_type(4)));
typedef float f32x4 __attribute__((ext_vector_type(4)));
typedef short bf16x8 __attribute__((ext_vector_type(8)));
typedef GAS unsigned gu32;
typedef GAS unsigned long long gu64;
#define RLX_AGENT __ATOMIC_RELAXED, __HIP_MEMORY_SCOPE_AGENT
#define LDS_WAIT() asm volatile("s_waitcnt lgkmcnt(0)" ::: "memory")
#define VM_WAIT() asm volatile("s_waitcnt vmcnt(0)" ::: "memory")
__device__ __forceinline__ unsigned long long rt() { return __builtin_amdgcn_s_memrealtime(); }
__device__ __forceinline__ unsigned f2bf(float f) { unsigned u = __builtin_bit_cast(unsigned, f); return (u + 0x7fffu + ((u >> 16) & 1u)) >> 16; }
__device__ __forceinline__ unsigned pk2(float lo, float hi) { return f2bf(lo) | (f2bf(hi) << 16); }
#define XB_TMO      128
#define XB_XCNT(j)  (256  + 64 * (j))
#define XB_XSUB(j)  (1280 + 64 * (j))
#define XB_XGEN(j)  (2304 + 64 * (j))
#define XB_TOP      3328
#define XB_TOPGEN   3392
#define XCD_BAR_WORDS 3456
#define XB_SPIN_CAP (1u << 18)

__device__ __forceinline__ unsigned xb_ld(unsigned* p)              { return __hip_atomic_load(p, __ATOMIC_RELAXED, __HIP_MEMORY_SCOPE_AGENT); }
__device__ __forceinline__ unsigned xb_add(unsigned* p, unsigned v) { return __hip_atomic_fetch_add(p, v, __ATOMIC_RELAXED, __HIP_MEMORY_SCOPE_AGENT); }
__device__ __forceinline__ unsigned xb_xcc_id() { return (unsigned)__builtin_amdgcn_s_getreg((3 << 11) | 20) & 0xFu; }
#define XB_SPIN(cond, bar) do { unsigned _sp = 0; while (cond) { __builtin_amdgcn_s_sleep(1); \
    if ((++_sp & 255u) == 0u) { if (xb_ld(&(bar)[XB_TMO])) break; if (_sp > XB_SPIN_CAP) { atomicAdd(&(bar)[XB_TMO], 1u); break; } } } } while (0)

struct XcdBarrier {
    unsigned* bar; unsigned x;
    volatile LAS unsigned* st;
};

__device__ __forceinline__ XcdBarrier xcd_barrier_post(unsigned* bar, volatile LAS unsigned* st) {
    XcdBarrier b; b.bar = bar; b.x = xb_xcc_id(); b.st = st;
    if (threadIdx.x == 0) (void)xb_add(&bar[XB_XCNT(b.x)], 1u);
    return b;
}
__device__ __forceinline__ void xcd_barrier_complete(unsigned* bar, unsigned x, unsigned& nloc, unsigned& nx) {
    const unsigned G = gridDim.x * gridDim.y * gridDim.z;
    unsigned sum, cnt, mine, sp = 0u;
    for (;;) {
        sum = 0u; cnt = 0u; mine = 0u;
#pragma unroll
        for (unsigned j = 0; j < 16; ++j) { const unsigned c = xb_ld(&bar[XB_XCNT(j)]); sum += c; cnt += (c > 0u) ? 1u : 0u; mine = (j == x) ? c : mine; }
        if (sum == G) break;
        __builtin_amdgcn_s_sleep(1);
        if ((++sp & 255u) == 0u) { if (xb_ld(&bar[XB_TMO])) break; if (sp > XB_SPIN_CAP) { atomicAdd(&bar[XB_TMO], 1u); break; } }
    }
    nloc = mine > 0u ? mine : 1u; nx = cnt > 0u ? cnt : 1u;
}

__device__ __forceinline__ void xcd_barrier(const XcdBarrier& b) {
    asm volatile("s_waitcnt vmcnt(0)" ::: "memory");
    __syncthreads();
    if (threadIdx.x == 0) {
        unsigned* bar = b.bar;
        __builtin_amdgcn_s_waitcnt(0);
        unsigned nloc = b.st[0], nx = b.st[1];
        if (nloc == 0u) { xcd_barrier_complete(bar, b.x, nloc, nx); b.st[0] = nloc; b.st[1] = nx; }
        const unsigned old = xb_add(&bar[XB_XSUB(b.x)], 1u);
        const unsigned gen = old / nloc;
        if (old + 1u == (gen + 1u) * nloc) {
            __builtin_amdgcn_fence(__ATOMIC_RELEASE, "agent");
            asm volatile("s_waitcnt vmcnt(0)" ::: "memory");
            const unsigned og = xb_add(&bar[XB_TOP], 1u);
            const unsigned tg = og / nx;
            if (og + 1u == (tg + 1u) * nx) xb_add(&bar[XB_TOPGEN], 1u);
            else XB_SPIN(xb_ld(&bar[XB_TOPGEN]) == tg, bar);
            __builtin_amdgcn_fence(__ATOMIC_ACQUIRE, "agent");
            xb_add(&bar[XB_XGEN(b.x)], 1u);
            asm volatile("s_waitcnt vmcnt(0)" ::: "memory");
        } else {
            XB_SPIN(xb_ld(&bar[XB_XGEN(b.x)]) == gen, bar);
            __builtin_amdgcn_fence(__ATOMIC_ACQUIRE, "agent");
            asm volatile("s_waitcnt vmcnt(0)" ::: "memory");
        }
    }
    __syncthreads();
}

constexpr int NWAVES = 8, NTHREADS = 512;
constexpr int RING_BYTES = 131072, LDSCTL_OFF = RING_BYTES, MISC_OFF = LDSCTL_OFF + 320, LDS_BYTES = 147456;

struct Args { const float* x; const int* pos; const float *ln_g, *w_in, *qn_g, *w_q_b, *kvn_g, *w_kv_b, *hg_lb, *hg_ng, *w_out, *fn_g; float* out; unsigned char* ws; int ph_lo, ph_hi; };

__device__ __forceinline__ float wave_sum(float v) {
#pragma unroll
    for (int o = 1; o < 64; o <<= 1) v += __shfl_xor(v, o);
    return v;
}
__device__ __forceinline__ int tid_opaque() { int t = threadIdx.x; asm volatile("" : "+v"(t)); return t; }
__device__ __forceinline__ float bf2f(bf16 b) { return __builtin_bit_cast(float, (unsigned)b << 16); }

__device__ const double INV_FREQ[16] = {1.0, 0.5623413251903491, 0.31622776601683794, 0.1778279410038923, 0.1, 0.05623413251903491, 0.03162277660168379, 0.01778279410038923,
                                        0.01, 0.005623413251903491, 0.0031622776601683794, 0.0017782794100389228, 0.001, 0.0005623413251903491, 0.00031622776601683794, 0.00017782794100389227};
__device__ __forceinline__ void p0_transpose_item(const float* W, int ldw, const float* kscale, bf16* WT, int ldt, int k0, int src_n0, int dst_n0, LAS float* scr, int lane) {
#pragma unroll 8
    for (int i = 0; i < 32; ++i) { const int kk = 2 * i + (lane >> 5); float v = 0.f;
        if (src_n0 >= 0) { v = W[(size_t)(k0 + kk) * ldw + src_n0 + (lane & 31)]; if (kscale) v *= kscale[k0 + kk]; }
        scr[kk * 33 + (lane & 31)] = v; }
    LDS_WAIT(); asm volatile("" ::: "memory");
    const int c = lane & 7;
#pragma unroll
    for (int j = 0; j < 4; ++j) { const int n = (lane >> 3) + 8 * j; const LAS float* s = scr + (8 * c) * 33 + n;
        v4u o; o.x = pk2(s[0 * 33], s[1 * 33]); o.y = pk2(s[2 * 33], s[3 * 33]); o.z = pk2(s[4 * 33], s[5 * 33]); o.w = pk2(s[6 * 33], s[7 * 33]);
        *(GAS v4u*)(WT + (size_t)(dst_n0 + n) * ldt + k0 + 8 * c) = o; }
    LDS_WAIT(); asm volatile("" ::: "memory");
}
__device__ __forceinline__ int w1_src_col(int n0) {
    if (n0 < 416) return n0;
    if (n0 < 512) return -1;
    if (n0 < 1024) return C_GMLA + (n0 - 512);
    if (n0 < 2048) { const int h = (n0 - 1024) >> 8, w = (n0 - 1024) & 255; return w < 128 ? C_HQ + 128 * h + w : C_HF + 128 * h + (w - 128); }
    if (n0 < 2560) return C_HI + (n0 - 2048);
    return C_GHG + (n0 - 2560);
}
__device__ __forceinline__ void p0_prologue(const Args& a, LAS unsigned char* lds, int vcu, int G) {
    const int tid = tid_opaque(), lane = tid & 63, wave = __builtin_amdgcn_readfirstlane(tid >> 6);
    unsigned char* ws = a.ws;
    LAS float* scr = (LAS float*)(lds + wave * 16384);
    const int gw = vcu * NWAVES + wave, NGW = G * NWAVES;
    constexpr int I_1 = (DMODEL / 64) * (N1 / 32), I_Q = (QRANK / 64) * (NQ / 32), I_KV = (KVRANK / 64) * (NKV / 32), I_O = (DMODEL / 64) * (DMODEL / 32);
    for (int it = gw; it < I_1 + I_Q + I_KV + I_O; it += NGW) {
        int r = it;
        if (r < I_1) { const int nb = r % (N1 / 32), kb = r / (N1 / 32); p0_transpose_item(a.w_in, D_IN, nullptr, (bf16*)(ws + WS_W1T), DMODEL, 64 * kb, w1_src_col(32 * nb), 32 * nb, scr, lane); continue; } r -= I_1;
        if (r < I_Q) { const int nb = r % (NQ / 32), kb = r / (NQ / 32); p0_transpose_item(a.w_q_b, NQ, a.qn_g, (bf16*)(ws + WS_WQT), QRANK, 64 * kb, 32 * nb, 32 * nb, scr, lane); continue; } r -= I_Q;
        if (r < I_KV) { const int nb = r % (NKV / 32), kb = r / (NKV / 32); p0_transpose_item(a.w_kv_b, NKV, a.kvn_g, (bf16*)(ws + WS_WKVT), KVRANK, 64 * kb, 32 * nb, 32 * nb, scr, lane); continue; } r -= I_KV;
        { const int nb = r % (DMODEL / 32), kb = r / (DMODEL / 32); p0_transpose_item(a.w_out, DMODEL, nullptr, (bf16*)(ws + WS_WOT), DMODEL, 64 * kb, 32 * nb, 32 * nb, scr, lane); }
    }
    f32x4 gv[4];
#pragma unroll
    for (int j = 0; j < 4; ++j) gv[j] = *((const f32x4*)a.ln_g + lane + 64 * j);
    for (int m = gw; m < MTOK; m += NGW) {
        const GAS f32x4* xr = (const GAS f32x4*)(a.x + (size_t)m * DMODEL) + lane;
        f32x4 v[4]; float s = 0.f;
#pragma unroll
        for (int j = 0; j < 4; ++j) { v[j] = xr[64 * j]; s += (v[j].x * v[j].x + v[j].y * v[j].y) + (v[j].z * v[j].z + v[j].w * v[j].w); }
        const float rstd = rsqrtf(wave_sum(s) * (1.f / DMODEL) + EPS);
        GAS unsigned long long* o8 = (GAS unsigned long long*)((bf16*)(ws + WS_XN) + (size_t)m * DMODEL) + lane;
#pragma unroll
        for (int j = 0; j < 4; ++j) { const f32x4 y = v[j] * rstd * gv[j]; o8[64 * j] = (unsigned long long)pk2(y.x, y.y) | ((unsigned long long)pk2(y.z, y.w) << 32); }
    }
    { const int gt = vcu * NTHREADS + wave * 64 + lane, NGT = G * NTHREADS;
      float2* cs = (float2*)(ws + WS_CS);
      for (int e = gt; e < MTOK * 16; e += NGT) { const int m = e >> 4, i = e & 15;
          double r = (double)a.pos[m] * INV_FREQ[i] * 0.15915494309189535; r -= floor(r);
          const float rf = (float)r; cs[e] = make_float2(__builtin_amdgcn_cosf(rf), __builtin_amdgcn_sinf(rf)); }
      if (gt < HGW) { const float a0 = a.hg_lb[gt], a1 = a.hg_lb[HGW + gt]; ((float*)(ws + WS_LB))[gt] = 1.f / (1.f + expf(a1 - a0)); }
    }
}

__device__ __forceinline__ void naive_attn_unit(int unit, const Args& a, LAS unsigned char* lds) {
    const int tid = tid_opaque();
    unsigned char* ws = a.ws;
    const bf16* Q = (const bf16*)(ws + WS_Q); const bf16* KN = (const bf16*)(ws + WS_KN); const bf16* KPE = (const bf16*)(ws + WS_KPE); const bf16* V = (const bf16*)(ws + WS_V);
    const bf16* GM = (const bf16*)(ws + WS_GMLA); bf16* Y = (bf16*)(ws + WS_Y);
    const int qb = unit & 7, h = (unit >> 3) & 7, b = unit >> 6;
    LAS float* Ks = (LAS float*)lds; LAS float* Vs = Ks + 64 * QHD;
    const int qrow = qb * 512 + tid; const size_t grow = (size_t)b * SEQ + qrow;
    float q[QHD], o[VDIM];
#pragma unroll
    for (int d = 0; d < QHD; ++d) q[d] = bf2f(Q[grow * NQ + h * QHD + d]);
#pragma unroll
    for (int d = 0; d < VDIM; ++d) o[d] = 0.f;
    float mx = -1e30f, l = 0.f;
    const int nt = (qb * 512 + 512) / 64;
    for (int j = 0; j < nt; ++j) {
        __syncthreads();
        for (int idx = tid; idx < 64 * QHD; idx += NTHREADS) { const int key = idx / QHD, d = idx % QHD; const size_t kr = (size_t)b * SEQ + 64 * j + key;
            Ks[idx] = d < NOPE ? bf2f(KN[kr * 512 + h * NOPE + d]) : bf2f(KPE[kr * ROPE + (d - NOPE)]); }
        for (int idx = tid; idx < 64 * VDIM; idx += NTHREADS) { const int key = idx / VDIM, d = idx % VDIM; Vs[idx] = bf2f(V[((size_t)b * SEQ + 64 * j + key) * 512 + h * VDIM + d]); }
        __syncthreads();
        for (int key = 0; key < 64; ++key) {
            if (64 * j + key <= qrow) {
                float s = 0.f;
#pragma unroll
                for (int d = 0; d < QHD; ++d) s += q[d] * Ks[key * QHD + d];
                if (s > mx) { const float al = exp2f(mx - s); l *= al;
#pragma unroll
                    for (int d = 0; d < VDIM; ++d) o[d] *= al;
                    mx = s; }
                const float p = exp2f(s - mx); l += p;
#pragma unroll
                for (int d = 0; d < VDIM; ++d) o[d] += p * Vs[key * VDIM + d];
            }
        }
    }
    const float rl = 1.f / l;
#pragma unroll
    for (int d = 0; d < VDIM; d += 2) { const float y0 = o[d] * rl * bf2f(GM[grow * 512 + h * VDIM + d]), y1 = o[d + 1] * rl * bf2f(GM[grow * 512 + h * VDIM + d + 1]);
        *(unsigned*)(Y + grow * DMODEL + h * VDIM + d) = pk2(y0, y1); }
    __syncthreads();
}
__device__ __forceinline__ void naive_scan_unit(int unit, const Args& a, LAS unsigned char* lds) {
    const int tid = tid_opaque();
    unsigned char* ws = a.ws;
    const bf16* QG = (const bf16*)(ws + WS_QG); const bf16* KG = (const bf16*)(ws + WS_KG); const bf16* HV = (const bf16*)(ws + WS_HV);
    const float* ER = (const float*)(ws + WS_ER); const float* EER = (const float*)(ws + WS_EER); float* OS = (float*)(ws + WS_OS);
    const int h = unit & 3, b = unit >> 2;
    LAS float* kgs = (LAS float*)lds; LAS float* qgs = kgs + 128; LAS float* vs = qgs + 128; LAS float* part = vs + 128; LAS float* ers = part + 512; LAS float* eers = ers + 128;
    const int v = tid & 127, kq = tid >> 7;
    float S[32];
#pragma unroll
    for (int i = 0; i < 32; ++i) S[i] = 0.f;
    for (int c = 0; c < NCHUNK; ++c) {
        const size_t gch = (size_t)b * NCHUNK + c;
        __syncthreads();
        if (tid < 128) ers[tid] = ER[gch * HGW + h * HGD + tid]; else if (tid < 256) eers[tid - 128] = EER[gch * HGW + h * HGD + tid - 128];
        __syncthreads();
#pragma unroll
        for (int i = 0; i < 32; ++i) S[i] *= ers[kq * 32 + i];
        for (int t = 0; t < CHUNK; ++t) {
            const size_t row = (size_t)b * SEQ + c * CHUNK + t;
            if (tid < 128) kgs[tid] = bf2f(KG[row * HGW + h * HGD + tid]); else if (tid < 256) qgs[tid - 128] = bf2f(QG[row * HGW + h * HGD + tid - 128]); else if (tid < 384) vs[tid - 256] = bf2f(HV[row * HGW + h * HGD + tid - 256]);
            __syncthreads();
            const float vv = vs[v]; float po = 0.f;
#pragma unroll
            for (int i = 0; i < 32; ++i) { S[i] += kgs[kq * 32 + i] * vv; po += S[i] * qgs[kq * 32 + i]; }
            part[kq * 128 + v] = po;
            __syncthreads();
            if (tid < 128) OS[row * HGW + h * HGD + tid] = (part[tid] + part[128 + tid]) + (part[256 + tid] + part[384 + tid]);
        }
#pragma unroll
        for (int i = 0; i < 32; ++i) S[i] *= eers[kq * 32 + i];
    }
    __syncthreads();
}
__device__ __forceinline__ void scan_norm_phase(const Args& a, int vcu, int G) {
    const int tid = tid_opaque(), lane = tid & 63, wave = __builtin_amdgcn_readfirstlane(tid >> 6);
    unsigned char* ws = a.ws; const float* OS = (const float*)(ws + WS_OS); const bf16* GH = (const bf16*)(ws + WS_GHG); bf16* Y = (bf16*)(ws + WS_Y);
    const int gw = vcu * NWAVES + wave, NGW = G * NWAVES;
    for (int idx = gw; idx < MTOK * HGH; idx += NGW) { const size_t row = idx >> 2; const int h = idx & 3, c = h * HGD + 2 * lane;
        const float2 o = *(const float2*)(OS + row * HGW + c); const float rstd = rsqrtf(wave_sum(o.x * o.x + o.y * o.y) * (1.f / HGD) + EPS);
        const unsigned gg = *(const unsigned*)(GH + row * HGW + c);
        const float y0 = o.x * rstd * bf2f((bf16)(gg & 0xffffu)), y1 = o.y * rstd * bf2f((bf16)(gg >> 16));
        *(unsigned*)(Y + row * DMODEL + MLAW + c) = pk2(y0, y1); }
}
__device__ __forceinline__ void final_norm_phase(const Args& a, int vcu, int G) {
    const int tid = tid_opaque(), lane = tid & 63, wave = __builtin_amdgcn_readfirstlane(tid >> 6);
    const float* SSQO = (const float*)(a.ws + WS_SSQO);
    const int gw = vcu * NWAVES + wave, NGW = G * NWAVES;
    f32x4 gv[4];
#pragma unroll
    for (int j = 0; j < 4; ++j) gv[j] = *((const f32x4*)a.fn_g + lane + 64 * j);
    for (int m = gw; m < MTOK; m += NGW) {
        float s = (lane < 16) ? SSQO[(size_t)m * 16 + lane] : 0.f; s = wave_sum(s);
        const float rstd = rsqrtf(s * (1.f / DMODEL) + EPS);
        GAS f32x4* orow = (GAS f32x4*)(a.out + (size_t)m * DMODEL) + lane;
#pragma unroll
        for (int j = 0; j < 4; ++j) { const f32x4 v = orow[64 * j]; orow[64 * j] = v * rstd * gv[j]; }
    }
}

namespace at {
typedef short bf16x8 __attribute__((ext_vector_type(8)));
typedef short s16x4 __attribute__((ext_vector_type(4)));
typedef short v4i16_t __attribute__((ext_vector_type(4)));
typedef float f32x16 __attribute__((ext_vector_type(16)));
typedef float f32x4 __attribute__((ext_vector_type(4)));
typedef unsigned u32x4 __attribute__((ext_vector_type(4)));
typedef LAS const char* lcp;
constexpr int QB = 256, KVBLK = 64, KROW = 208  , KBUF = 64 * KROW, VBUF = 64 * 128;
constexpr int NKS = 3, NVS = 4;
constexpr int L_K = 0, L_V = NKS * KBUF, L_WS = L_V + NVS * VBUF, L_OST = 0  , L_END = L_WS + 8 * 256;
static_assert(L_END <= RING_BYTES && 8 * 8192 <= L_WS, "attention LDS map");
constexpr float THR = 8.f;
#define SBAR() __builtin_amdgcn_sched_barrier(0)
#define MFMA32(a, b, c) __builtin_amdgcn_mfma_f32_32x32x16_bf16(a, b, c, 0, 0, 0)
__device__ __forceinline__ int crow(int r, int hi) { return (r & 3) + 8 * (r >> 2) + 4 * hi; }
__device__ __forceinline__ unsigned cvtpk(float lo, float hi) { unsigned r; asm volatile("v_cvt_pk_bf16_f32 %0, %1, %2" : "=v"(r) : "v"(lo), "v"(hi)); return r; }
__device__ __forceinline__ s16x4 vtr(lcp p) { return __builtin_bit_cast(s16x4, __builtin_amdgcn_ds_read_tr16_b64_v4i16((LAS v4i16_t*)p)); }
__device__ __forceinline__ void mask_tile(f32x16& p0, f32x16& p1, int dq) {
    const float NEG = -__builtin_inff();
#pragma unroll
    for (int r = 0; r < 16; ++r) { const int c = (r & 3) + 8 * (r >> 2); if (dq - c < 0) p0[r] = NEG; if (dq - c - 32 < 0) p1[r] = NEG; }
}
__device__ __forceinline__ void partialSM(f32x16& p0, f32x16& p1, float& m_reg, float& alpha) {
    float pmax = p0[0];
#pragma unroll
    for (int r = 1; r < 16; ++r) pmax = fmaxf(pmax, p0[r]);
#pragma unroll
    for (int r = 0; r < 16; ++r) pmax = fmaxf(pmax, p1[r]);
    { auto rr = __builtin_amdgcn_permlane32_swap(__float_as_uint(pmax), __float_as_uint(pmax), false, false); pmax = fmaxf(__uint_as_float(rr[0]), __uint_as_float(rr[1])); }
    float mn;
    if (__builtin_expect(__all(pmax - m_reg <= THR), 1)) { mn = m_reg; alpha = 1.f; }
    else { mn = fmaxf(m_reg, pmax); alpha = __builtin_amdgcn_exp2f(m_reg - mn); m_reg = mn; }
#pragma unroll
    for (int r = 0; r < 16; ++r) { p0[r] -= mn; p1[r] -= mn; }
#pragma unroll
    for (int r = 0; r < 16; ++r) p0[r] = __builtin_amdgcn_exp2f(p0[r]);
}
__device__ __forceinline__ void finishSM(f32x16& p0, f32x16& p1, float alpha, float& l_reg, bf16x8& pa0, bf16x8& pa1, bf16x8& pa2, bf16x8& pa3) {
#pragma unroll
    for (int r = 0; r < 16; ++r) p1[r] = __builtin_amdgcn_exp2f(p1[r]);
    float ps = 0.f;
#pragma unroll
    for (int r = 0; r < 16; ++r) ps += p0[r];
#pragma unroll
    for (int r = 0; r < 16; ++r) ps += p1[r];
    { auto rr = __builtin_amdgcn_permlane32_swap(__float_as_uint(ps), __float_as_uint(ps), false, false); ps = __uint_as_float(rr[0]) + __uint_as_float(rr[1]); }
    l_reg = l_reg * alpha + ps;
#define PK4(P, B_, OUT) do { unsigned a0 = cvtpk(P[B_+0], P[B_+1]), a1 = cvtpk(P[B_+2], P[B_+3]); unsigned b0 = cvtpk(P[B_+4], P[B_+5]), b1 = cvtpk(P[B_+6], P[B_+7]); \
        auto r0 = __builtin_amdgcn_permlane32_swap(a0, b0, false, false); auto r1 = __builtin_amdgcn_permlane32_swap(a1, b1, false, false); \
        u32x4 w = {r0[0], r1[0], r0[1], r1[1]}; OUT = __builtin_bit_cast(bf16x8, w); } while (0)
    PK4(p0, 0, pa0); PK4(p0, 8, pa1); PK4(p1, 0, pa2); PK4(p1, 8, pa3);
#undef PK4
}
__device__ __forceinline__ void qkt(f32x16& p0, f32x16& p1, lcp a, const bf16x8* qr) {
    p0 = f32x16{}; p1 = f32x16{};
#pragma unroll
    for (int d0 = 0; d0 < 6; ++d0) {
        const bf16x8 b0 = *(const LAS bf16x8*)(a + d0 * 32);
        const bf16x8 b1 = *(const LAS bf16x8*)(a + d0 * 32 + 32 * KROW);
        p0 = MFMA32(b0, qr[d0], p0); p1 = MFMA32(b1, qr[d0], p1);
    }
}
__device__ __forceinline__ void pv_tile(f32x16* o, lcp a, bf16x8 pa0, bf16x8 pa1, bf16x8 pa2, bf16x8 pa3) {
#pragma unroll
    for (int d0 = 0; d0 < 2; ++d0) {
        s16x4 l0 = vtr(a + d0 * 512), h0 = vtr(a + d0 * 512 + 256), l1 = vtr(a + 2048 + d0 * 512), h1 = vtr(a + 2048 + d0 * 512 + 256);
        s16x4 l2 = vtr(a + 4096 + d0 * 512), h2 = vtr(a + 4096 + d0 * 512 + 256), l3 = vtr(a + 6144 + d0 * 512), h3 = vtr(a + 6144 + d0 * 512 + 256);
        o[d0] = MFMA32(pa0, ((bf16x8){l0[0], l0[1], l0[2], l0[3], h0[0], h0[1], h0[2], h0[3]}), o[d0]);
        o[d0] = MFMA32(pa1, ((bf16x8){l1[0], l1[1], l1[2], l1[3], h1[0], h1[1], h1[2], h1[3]}), o[d0]);
        o[d0] = MFMA32(pa2, ((bf16x8){l2[0], l2[1], l2[2], l2[3], h2[0], h2[1], h2[2], h2[3]}), o[d0]);
        o[d0] = MFMA32(pa3, ((bf16x8){l3[0], l3[1], l3[2], l3[3], h3[0], h3[1], h3[2], h3[3]}), o[d0]);
    }
}

__device__ __forceinline__ void attn_unit(int b, int h, int qb, unsigned char* ws, LAS unsigned char* lds) {
    const int tid = tid_opaque(), lane = tid & 63, r32 = lane & 31, hi = lane >> 5; const int wid = __builtin_amdgcn_readfirstlane(tid >> 6);
    const bf16* Q = (const bf16*)(ws + WS_Q); const bf16* KN = (const bf16*)(ws + WS_KN); const bf16* KPE = (const bf16*)(ws + WS_KPE); const bf16* V = (const bf16*)(ws + WS_V);
    const bf16* GM = (const bf16*)(ws + WS_GMLA); bf16* Y = (bf16*)(ws + WS_Y);
    const size_t rowbase = (size_t)b * SEQ; const int q0 = qb * QB, NT = (q0 + QB) / KVBLK;
    const int skey = tid >> 3, sch = tid & 7, pkey = (tid >> 2) & 63, pch = tid & 3; const bool pe = wid < 4;
    const bf16* kn_src = KN + (rowbase + skey) * 512 + h * NOPE + sch * 8; const bf16* v_src = V + (rowbase + skey) * 512 + h * VDIM + sch * 8;
    const bf16* kp_src = KPE + (rowbase + pkey) * ROPE + pch * 8;
    LAS unsigned char* kn_dst = lds + L_K + skey * KROW + sch * 16; LAS unsigned char* kp_dst = lds + L_K + pkey * KROW + 128 + pch * 16;
    LAS unsigned char* v_dst = lds + L_V + ((skey >> 3) * 2 + (sch >> 2)) * 512 + (skey & 7) * 64 + (sch & 3) * 16;
    bf16x8 st_kn, st_kp, st_v;
#define SLOAD(t) do { st_kn = *(const bf16x8*)(kn_src + (size_t)(t) * KVBLK * 512); st_v = *(const bf16x8*)(v_src + (size_t)(t) * KVBLK * 512); if (pe) st_kp = *(const bf16x8*)(kp_src + (size_t)(t) * KVBLK * ROPE); } while (0)
#define SWRITE(ks_, vs_) do { *(LAS bf16x8*)(kn_dst + (ks_) * KBUF) = st_kn; *(LAS bf16x8*)(v_dst + (vs_) * VBUF) = st_v; if (pe) *(LAS bf16x8*)(kp_dst + (ks_) * KBUF) = st_kp; } while (0)
    lcp kp = (lcp)lds + L_K + r32 * KROW + hi * 16;
    lcp vp = (lcp)lds + L_V + hi * 1024 + ((lane >> 2) & 3) * 64 + ((lane >> 4) & 1) * 32 + (lane & 3) * 8;
    LAS float* wsf = (LAS float*)(lds + L_WS) + wid * 64; LAS float* li_l = wsf; LAS float* al_l = wsf + 32;
    bf16x8 qr[6];
    { const bf16* qw = Q + (rowbase + q0 + wid * 32 + r32) * NQ + h * QHD + hi * 8;
#pragma unroll
      for (int d0 = 0; d0 < 6; ++d0) qr[d0] = *(const bf16x8*)(qw + d0 * 16); }
    const int qlo = q0 + wid * 32, qm = qlo + r32 - 4 * hi;
    float m_reg = -1e30f, l_reg = 0.f; f32x16 o[2]; o[0] = f32x16{}; o[1] = f32x16{};
#define MASKT(P0_, P1_, t) do { const int kb_ = (t) * KVBLK; if (kb_ + KVBLK - 1 > qlo) mask_tile(P0_, P1_, qm - kb_); } while (0)
#define RESC(a_) do { if (__any((a_) < 1.f)) { if (hi == 0) al_l[r32] = (a_); \
        _Pragma("unroll") for (int d_ = 0; d_ < 2; ++d_) _Pragma("unroll") for (int r = 0; r < 16; ++r) o[d_][r] *= al_l[crow(r, hi)]; } } while (0)
    f32x16 pA0, pA1, pB0, pB1; float alA, alB; bf16x8 pa0, pa1, pa2, pa3;
    __syncthreads();
    SLOAD(0); SWRITE(0, 0); SLOAD(1); SWRITE(1, 1);
    __syncthreads();
    int ks0 = 0, ks2 = 2, vs0 = 0, vsm = 3, vs2 = 2;
#define ROT() do { ks0 = (ks0 == NKS - 1) ? 0 : ks0 + 1; ks2 = (ks2 == NKS - 1) ? 0 : ks2 + 1; vsm = vs0; vs0 = (vs0 == NVS - 1) ? 0 : vs0 + 1; vs2 = (vs2 == NVS - 1) ? 0 : vs2 + 1; } while (0)
    SLOAD(2);
    qkt(pA0, pA1, kp + ks0 * KBUF, qr); MASKT(pA0, pA1, 0); partialSM(pA0, pA1, m_reg, alA);
    SWRITE(ks2, vs2); ROT();
    __syncthreads();
#define STEP(PX0, PX1, alX, PY0, PY1, alY, t) do { \
        if ((t) + 2 < NT) { SLOAD((t) + 2); } SBAR(); \
        qkt(PX0, PX1, kp + ks0 * KBUF, qr); \
        finishSM(PY0, PY1, alY, l_reg, pa0, pa1, pa2, pa3); SBAR(); \
        pv_tile(o, vp + vsm * VBUF, pa0, pa1, pa2, pa3); MASKT(PX0, PX1, (t)); partialSM(PX0, PX1, m_reg, alX); \
        RESC(alX); \
        if ((t) + 2 < NT) { SWRITE(ks2, vs2); } ROT(); \
        __syncthreads(); } while (0)
    STEP(pB0, pB1, alB, pA0, pA1, alA, 1);
    for (int t = 2; t < NT; t += 2) {
        STEP(pA0, pA1, alA, pB0, pB1, alB, t);
        STEP(pB0, pB1, alB, pA0, pA1, alA, t + 1);
    }
    finishSM(pB0, pB1, alB, l_reg, pa0, pa1, pa2, pa3); SBAR();
    pv_tile(o, vp + vsm * VBUF, pa0, pa1, pa2, pa3);
    if (hi == 0) li_l[r32] = l_reg;
    __syncthreads();
    LAS float* stg = (LAS float*)(lds + L_OST) + wid * 2048;
#pragma unroll
    for (int r = 0; r < 16; ++r) { const int orow = crow(r, hi); const float rl = __builtin_amdgcn_rcpf(li_l[orow]);
#pragma unroll
        for (int d0 = 0; d0 < 2; ++d0) stg[orow * 64 + d0 * 32 + r32] = o[d0][r] * rl; }
#pragma unroll
    for (int i = 0; i < 4; ++i) { const int row = i * 8 + (lane >> 3), ch = lane & 7; const size_t grow = rowbase + q0 + wid * 32 + row;
        const f32x4 x0 = *(const LAS f32x4*)(stg + row * 64 + ch * 8), x1 = *(const LAS f32x4*)(stg + row * 64 + ch * 8 + 4);
        const u32x4 g = *(const u32x4*)(GM + grow * 512 + h * VDIM + ch * 8);
        u32x4 w;
        w.x = cvtpk(x0[0] * __uint_as_float(g.x << 16), x0[1] * __uint_as_float(g.x & 0xffff0000u)); w.y = cvtpk(x0[2] * __uint_as_float(g.y << 16), x0[3] * __uint_as_float(g.y & 0xffff0000u));
        w.z = cvtpk(x1[0] * __uint_as_float(g.z << 16), x1[1] * __uint_as_float(g.z & 0xffff0000u)); w.w = cvtpk(x1[2] * __uint_as_float(g.w << 16), x1[3] * __uint_as_float(g.w & 0xffff0000u));
        *(u32x4*)(Y + grow * DMODEL + h * VDIM + ch * 8) = w; }
#undef SLOAD
#undef SWRITE
#undef MASKT
#undef RESC
#undef STEP
#undef ROT
}
#undef SBAR
#undef MFMA32
}

namespace sc {
typedef short bf16x8 __attribute__((ext_vector_type(8)));
typedef short s16x4 __attribute__((ext_vector_type(4)));
typedef short v4i16_t __attribute__((ext_vector_type(4)));
typedef float f32x16 __attribute__((ext_vector_type(16)));
typedef float f32x4 __attribute__((ext_vector_type(4)));
typedef unsigned u32x4 __attribute__((ext_vector_type(4)));
typedef unsigned u32x2 __attribute__((ext_vector_type(2)));
typedef LAS const char* lcp;
constexpr int TILE = 16384;
constexpr int L_T = 0, L_S = 3 * TILE, L_O = L_S + 2 * TILE, OPITCH = 528;
constexpr int L_ER = RING_BYTES + 1024, L_SSQ = L_ER + 2048;
static_assert(L_O + 64 * OPITCH <= RING_BYTES && L_SSQ + 1024 <= LDS_BYTES, "scan LDS map");
#define MFMA32(a, b, c) __builtin_amdgcn_mfma_f32_32x32x16_bf16(a, b, c, 0, 0, 0)
#define SBAR() __builtin_amdgcn_sched_barrier(0)
__device__ __forceinline__ unsigned off_a(unsigned row, unsigned ch) { return 2048u * (row >> 3) + 512u * (ch >> 2) + 64u * (row & 7) + 16u * ((ch & 3) ^ ((row >> 2) & 3)); }
__device__ __forceinline__ unsigned cvtpk(float lo, float hi) { unsigned r; asm volatile("v_cvt_pk_bf16_f32 %0, %1, %2" : "=v"(r) : "v"(lo), "v"(hi)); return r; }
__device__ __forceinline__ s16x4 vtr(lcp p) { return __builtin_bit_cast(s16x4, __builtin_amdgcn_ds_read_tr16_b64_v4i16((LAS v4i16_t*)p)); }
__device__ __forceinline__ bf16x8 cat8(s16x4 l, s16x4 h) { return (bf16x8){l[0], l[1], l[2], l[3], h[0], h[1], h[2], h[3]}; }
__device__ __forceinline__ void pack2(const f32x16& p, bf16x8& f0, bf16x8& f1) {
#define PK4(B_, OUT) do { unsigned a0 = cvtpk(p[B_+0], p[B_+1]), a1 = cvtpk(p[B_+2], p[B_+3]); unsigned b0 = cvtpk(p[B_+4], p[B_+5]), b1 = cvtpk(p[B_+6], p[B_+7]); \
        auto r0 = __builtin_amdgcn_permlane32_swap(a0, b0, false, false); auto r1 = __builtin_amdgcn_permlane32_swap(a1, b1, false, false); \
        u32x4 w = {r0[0], r1[0], r0[1], r1[1]}; OUT = __builtin_bit_cast(bf16x8, w); } while (0)
    PK4(0, f0); PK4(8, f1);
#undef PK4
}

__device__ __forceinline__ void scan_unit(int unit, const Args& a, LAS unsigned char* lds) {
    unsigned char* ws = a.ws;
    const int tid = tid_opaque(), lane = tid & 63, l31 = lane & 31, hi = lane >> 5; const int wid = __builtin_amdgcn_readfirstlane(tid >> 6);
    const int th = wid >> 2, vb = wid & 3, h = unit & 3, b = unit >> 2;
    const bf16* QG = (const bf16*)(ws + WS_QG) + h * HGD; const bf16* KG = (const bf16*)(ws + WS_KG) + h * HGD; const bf16* HV = (const bf16*)(ws + WS_HV) + h * HGD;
    const bf16* GH = (const bf16*)(ws + WS_GHG) + h * HGD; bf16* Y = (bf16*)(ws + WS_Y) + MLAW + h * HGD;
    const float* ER = (const float*)(ws + WS_ER) + h * HGD; const float* EER = (const float*)(ws + WS_EER) + h * HGD;
    const size_t rowbase = (size_t)b * SEQ;
    const int srow = tid >> 4, sch = tid & 15; const unsigned sdst = off_a(srow, sch);
    const size_t ssrc = (rowbase + srow) * HGW + sch * 8;
    bf16x8 st[6]; u32x4 gt[2]; float st_e = 0.f;
#define SLOAD(c) do { const size_t o_ = ssrc + (size_t)(c) * CHUNK * HGW; \
        st[0] = *(const bf16x8*)(QG + o_); st[1] = *(const bf16x8*)(QG + o_ + 32 * HGW); st[2] = *(const bf16x8*)(KG + o_); st[3] = *(const bf16x8*)(KG + o_ + 32 * HGW); \
        st[4] = *(const bf16x8*)(HV + o_); st[5] = *(const bf16x8*)(HV + o_ + 32 * HGW); } while (0)
#define SWRITE() do { LAS unsigned char* d_ = lds + L_T + sdst; \
        *(LAS bf16x8*)(d_) = st[0]; *(LAS bf16x8*)(d_ + 8192) = st[1]; *(LAS bf16x8*)(d_ + TILE) = st[2]; *(LAS bf16x8*)(d_ + TILE + 8192) = st[3]; \
        *(LAS bf16x8*)(d_ + 2 * TILE) = st[4]; *(LAS bf16x8*)(d_ + 2 * TILE + 8192) = st[5]; } while (0)
#define GTLOAD(c) do { const size_t o_ = ssrc + (size_t)(c) * CHUNK * HGW; gt[0] = *(const u32x4*)(GH + o_); gt[1] = *(const u32x4*)(GH + o_ + 32 * HGW); } while (0)
#define ELOAD(c) do { if (wid < 2) st_e = ER[((size_t)b * NCHUNK + (c)) * HGW + tid]; else if (wid < 4) st_e = EER[((size_t)b * NCHUNK + (c)) * HGW + tid - 128]; } while (0)
#define EWRITE(slot) do { if (wid < 4) ((LAS float*)(lds + L_ER))[(slot) * 256 + tid] = st_e; } while (0)
    const unsigned x = (l31 >> 2) & 3;
    const unsigned rb_e = 2048u * (l31 >> 3) + 64u * (l31 & 7) + 16u * ((unsigned)hi ^ x), rb_o = 2048u * (l31 >> 3) + 64u * (l31 & 7) + 16u * ((2u + hi) ^ x);
    const unsigned q4 = (lane & 15) >> 2, p4 = lane & 3, blk = (lane >> 4) & 1;
    const unsigned tb0 = 2048u * hi + 64u * q4 + 16u * ((2u * blk + (p4 >> 1)) ^ (2u * hi)) + 8u * (p4 & 1);
    const unsigned tb1 = 2048u * hi + 64u * (4u + q4) + 16u * ((2u * blk + (p4 >> 1)) ^ (2u * hi + 1u)) + 8u * (p4 & 1);
    const unsigned wbase = 8192u * vb + 2048u * (l31 >> 3) + 64u * (l31 & 7) + 8u * hi;
    LAS float* ssq_l = (LAS float*)(lds + L_SSQ);
    lcp tQ = (lcp)lds + L_T, tK = tQ + TILE, tV = tQ + 2 * TILE, tS = (lcp)lds + L_S;
    f32x16 S0 = f32x16{}, S1 = f32x16{};
    __syncthreads();
    SLOAD(0); ELOAD(0); EWRITE(0);
    __syncthreads();
    for (int c = 0; c < NCHUNK; ++c) {
        const int eb = c & 1;
        const LAS float* er = (const LAS float*)(lds + L_ER) + eb * 256; const LAS float* eer = er + 128;
        SWRITE();
#pragma unroll
        for (int g = 0; g < 4; ++g) { const f32x4 e0 = *(const LAS f32x4*)(er + 64 * th + 8 * g + 4 * hi), e1 = *(const LAS f32x4*)(er + 64 * th + 32 + 8 * g + 4 * hi);
#pragma unroll
            for (int e = 0; e < 4; ++e) { S0[4 * g + e] *= e0[e]; S1[4 * g + e] *= e1[e]; }
            u32x2 w0, w1; w0.x = cvtpk(S0[4 * g], S0[4 * g + 1]); w0.y = cvtpk(S0[4 * g + 2], S0[4 * g + 3]); w1.x = cvtpk(S1[4 * g], S1[4 * g + 1]); w1.y = cvtpk(S1[4 * g + 2], S1[4 * g + 3]);
            *(LAS u32x2*)(lds + L_S + wbase + 512u * (2 * th) + 16u * ((unsigned)g ^ x)) = w0; *(LAS u32x2*)(lds + L_S + wbase + 512u * (2 * th + 1) + 16u * ((unsigned)g ^ x)) = w1; }
        __syncthreads();
        asm volatile("" ::: "memory");
        if (c + 1 < NCHUNK) { SLOAD(c + 1); ELOAD(c + 1); }
        GTLOAD(c);
        asm volatile("" ::: "memory");
#define RB(s) (((s) & 1) ? rb_o : rb_e) + 512 * ((s) >> 1)
        bf16x8 qf[8], kfa[8], vf[4];
#pragma unroll
        for (int s = 0; s < 8; ++s) qf[s] = *(const LAS bf16x8*)(tQ + 8192 * th + RB(s));
#pragma unroll
        for (int s = 0; s < 8; ++s) kfa[s] = *(const LAS bf16x8*)(tK + RB(s));
#pragma unroll
        for (int ks = 0; ks < 4; ++ks) vf[ks] = cat8(vtr(tV + tb0 + 4096 * ks + 512 * vb), vtr(tV + tb1 + 4096 * ks + 512 * vb));
        SBAR();
        f32x16 pA = f32x16{};
#pragma unroll
        for (int s = 0; s < 8; ++s) pA = MFMA32(kfa[s], qf[s], pA);
        bf16x8 sf[8], kfb[8];
#pragma unroll
        for (int s = 0; s < 8; ++s) sf[s] = *(const LAS bf16x8*)(tS + 8192 * vb + RB(s));
        if (th == 1) {
#pragma unroll
            for (int s = 0; s < 8; ++s) kfb[s] = *(const LAS bf16x8*)(tK + 8192 + RB(s)); }
        SBAR();
        f32x16 o = f32x16{};
#pragma unroll
        for (int s = 0; s < 8; ++s) o = MFMA32(sf[s], qf[s], o);
        bf16x8 pa[4]; pa[2] = bf16x8{}; pa[3] = bf16x8{};
        if (th == 0) {
#pragma unroll
            for (int r = 0; r < 16; ++r) if (((r & 3) + 8 * (r >> 2) + 4 * hi) > l31) pA[r] = 0.f; }
        pack2(pA, pa[0], pa[1]);
        if (th == 1) { f32x16 pB = f32x16{};
#pragma unroll
            for (int s = 0; s < 8; ++s) pB = MFMA32(kfb[s], qf[s], pB);
#pragma unroll
            for (int r = 0; r < 16; ++r) if (((r & 3) + 8 * (r >> 2) + 4 * hi) > l31) pB[r] = 0.f;
            pack2(pB, pa[2], pa[3]); }
        SBAR();
        bf16x8 kt[8];
#pragma unroll
        for (int ks = 0; ks < 4; ++ks) { kt[2 * ks] = cat8(vtr(tK + tb0 + 4096 * ks + 512 * (2 * th)), vtr(tK + tb1 + 4096 * ks + 512 * (2 * th)));
            kt[2 * ks + 1] = cat8(vtr(tK + tb0 + 4096 * ks + 512 * (2 * th + 1)), vtr(tK + tb1 + 4096 * ks + 512 * (2 * th + 1))); }
        SBAR();
        o = MFMA32(vf[0], pa[0], o); o = MFMA32(vf[1], pa[1], o);
        if (th == 1) { o = MFMA32(vf[2], pa[2], o); o = MFMA32(vf[3], pa[3], o); }
#pragma unroll
        for (int ks = 0; ks < 4; ++ks) { S0 = MFMA32(kt[2 * ks], vf[ks], S0); S1 = MFMA32(kt[2 * ks + 1], vf[ks], S1); }
#pragma unroll
        for (int g = 0; g < 4; ++g) { const f32x4 e0 = *(const LAS f32x4*)(eer + 64 * th + 8 * g + 4 * hi), e1 = *(const LAS f32x4*)(eer + 64 * th + 32 + 8 * g + 4 * hi);
#pragma unroll
            for (int e = 0; e < 4; ++e) { S0[4 * g + e] *= e0[e]; S1[4 * g + e] *= e1[e]; } }
#undef RB
        float ss = 0.f;
#pragma unroll
        for (int r = 0; r < 16; ++r) ss += o[r] * o[r];
        { auto rr = __builtin_amdgcn_permlane32_swap(__float_as_uint(ss), __float_as_uint(ss), false, false); ss = __uint_as_float(rr[0]) + __uint_as_float(rr[1]); }
        if (hi == 0) ssq_l[vb * 64 + 32 * th + l31] = ss;
#pragma unroll
        for (int g = 0; g < 4; ++g) *(LAS f32x4*)(lds + L_O + (32 * th + l31) * OPITCH + (32 * vb + 8 * g + 4 * hi) * 4) = (f32x4){o[4 * g], o[4 * g + 1], o[4 * g + 2], o[4 * g + 3]};
        if (c + 1 < NCHUNK) EWRITE(eb ^ 1);
        __syncthreads();
#pragma unroll
        for (int i = 0; i < 2; ++i) { const int row = srow + 32 * i;
            const float rstd = rsqrtf(((ssq_l[row] + ssq_l[64 + row]) + (ssq_l[128 + row] + ssq_l[192 + row])) * (1.f / HGD) + EPS);
            const f32x4 x0 = *(const LAS f32x4*)(lds + L_O + row * OPITCH + sch * 32), x1 = *(const LAS f32x4*)(lds + L_O + row * OPITCH + sch * 32 + 16);
            const u32x4 g = gt[i]; u32x4 w;
            w.x = cvtpk(x0[0] * rstd * __uint_as_float(g.x << 16), x0[1] * rstd * __uint_as_float(g.x & 0xffff0000u)); w.y = cvtpk(x0[2] * rstd * __uint_as_float(g.y << 16), x0[3] * rstd * __uint_as_float(g.y & 0xffff0000u));
            w.z = cvtpk(x1[0] * rstd * __uint_as_float(g.z << 16), x1[1] * rstd * __uint_as_float(g.z & 0xffff0000u)); w.w = cvtpk(x1[2] * rstd * __uint_as_float(g.w << 16), x1[3] * rstd * __uint_as_float(g.w & 0xffff0000u));
            *(u32x4*)(Y + (rowbase + (size_t)c * CHUNK + row) * DMODEL + sch * 8) = w; }
    }
#undef SLOAD
#undef SWRITE
#undef GTLOAD
#undef ELOAD
#undef EWRITE
}
#undef MFMA32
#undef SBAR
}

#ifndef MK_PER_PHASE
#define MK_PER_PHASE 0
#endif
#ifndef NAIVE_ATTN
#define NAIVE_ATTN 0
#endif
#ifndef NAIVE_SCAN
#define NAIVE_SCAN 0
#endif
#if NAIVE_SCAN
#define SCAN_UNIT(u) naive_scan_unit((u), a, lds)
#else
#define SCAN_UNIT(u) sc::scan_unit((u), a, lds)
#endif
#ifndef DUP_PHASE
#define DUP_PHASE -1
#endif
#define DUP(k) (DUP_PHASE == (k) ? 2 : 1)
#ifndef PROBE_SCAN_ALONE
#define PROBE_SCAN_ALONE 0
#endif
#ifndef DUP_SCAN
#define DUP_SCAN 1
#endif
constexpr int N_PHASES = 7;
__global__ void __launch_bounds__(NTHREADS, 2) hyb_fwd(Args a) {
    extern __shared__ __attribute__((aligned(16))) unsigned char lds_raw[];
    LAS unsigned char* lds = (LAS unsigned char*)lds_raw;
    const int G = gridDim.x; const int bx = blockIdx.x; const int vcu = (G % 8 == 0) ? (bx % 8) * (G / 8) + bx / 8 : bx;
    unsigned char* ws = a.ws;
    gu32* ctl = (gu32*)(ws + WS_CTL);
    volatile LAS unsigned* MISC = (volatile LAS unsigned*)(lds + MISC_OFF);
    for (int u = threadIdx.x; u < (LDS_BYTES - LDSCTL_OFF) / 4; u += NTHREADS) ((LAS unsigned*)(lds + LDSCTL_OFF))[u] = 0u;
    __syncthreads();
    const int lo = a.ph_lo, hi = a.ph_hi;
    const bool fusedl = (hi - lo) > 1;
    XcdBarrier bar; bar.bar = (unsigned*)(ctl + CW_BAR); bar.x = 0; bar.st = nullptr;
    if (fusedl) bar = xcd_barrier_post((unsigned*)(ctl + CW_BAR), MISC + 8);
#define IN(k) (lo <= (k) && (k) < hi)
#define SEAM(k) do { if (IN(k) && IN((k) + 1)) xcd_barrier(bar); } while (0)

#ifndef NO_P0
    if (IN(0)) { for (int rep = 0; rep < DUP(0); ++rep) p0_prologue(a, lds, vcu, G); SEAM(0); }
#endif

#ifndef NO_P1
    if (IN(1)) {
        pg8::Gemm g{(const bf16*)(ws + WS_XN), (const bf16*)(ws + WS_W1T), MTOK, N1, DMODEL}; pg8::StaticOrder S; S.init(MTOK, N1, G, bx);
        pg8::EpiP1 E{ws, a.hg_ng};
        for (int rep = 0; rep < DUP(1); ++rep) pg8::gemm_phase<pg8::EpiP1, pg8::StaticOrder, true, PG8_SP2>(lds, g, S, E);
        SEAM(1);
    }
#endif
#ifndef NO_P2
    if (IN(2)) {
      for (int rep = 0; rep < DUP(2); ++rep) {
        { pg8::Gemm g{(const bf16*)(ws + WS_QLAT), (const bf16*)(ws + WS_WQT), MTOK, NQ, QRANK}; pg8::StaticOrder S; S.init(MTOK, NQ, G, bx);
          pg8::EpiQ E{(bf16*)(ws + WS_Q), (const float*)(ws + WS_SSQQ), (const pg8::f32x2e*)(ws + WS_CS)};
          pg8::gemm_phase<pg8::EpiQ, pg8::StaticOrder, true, PG8_SP2>(lds, g, S, E); }
        { pg8::Gemm g{(const bf16*)(ws + WS_KVLAT), (const bf16*)(ws + WS_WKVT), MTOK, NKV, KVRANK}; pg8::StaticOrder S; S.init(MTOK, NKV, G, bx);
          pg8::EpiKV E{(bf16*)(ws + WS_KN), (bf16*)(ws + WS_V), (const float*)(ws + WS_SSQKV)};
          pg8::gemm_phase<pg8::EpiKV, pg8::StaticOrder, true, PG8_SP2>(lds, g, S, E); }
      }
        SEAM(2);
    }
#endif
#ifndef NO_P3
    if (IN(3)) {
#if NAIVE_ATTN
        if (bx < BATCH * HGH) naive_scan_unit(bx, a, lds);
        for (int u = bx; u < BATCH * NHEAD * (SEQ / 512); u += G) naive_attn_unit(u, a, lds);
#else
#if PROBE_SCAN_ALONE
        if (bx < BATCH * HGH) { for (int r2 = 0; r2 < DUP_SCAN; ++r2) SCAN_UNIT(bx); }
        xcd_barrier(bar);
#endif
        const unsigned xq = xb_xcc_id() & 7u;
        for (int rep = 0; rep < DUP(3); ++rep)
        for (unsigned qi = 0; qi < 8; ++qi) { const unsigned q = (xq + qi) & 7u;
            for (;;) {
                __syncthreads();
                if (threadIdx.x == 0) MISC[16] = __hip_atomic_fetch_add(ctl + CW_QUEUE + 64 * (q + 8 * rep), 1u, __ATOMIC_RELAXED, __HIP_MEMORY_SCOPE_AGENT);
                __syncthreads();
                const unsigned k = MISC[16];
                if (k >= 4 + 128) break;
                if (k < 4) { if (!PROBE_SCAN_ALONE) { for (int r2 = 0; r2 < DUP_SCAN; ++r2) SCAN_UNIT((int)(q * 4 + k)); } }
                else { const unsigned k2 = k - 4, bh = q * 8 + (k2 & 7); at::attn_unit((int)(bh >> 3), (int)(bh & 7), 15 - (int)(k2 >> 3), ws, lds); }
            }
        }
#endif
#if NAIVE_SCAN
        SEAM(3);
#else
        if (IN(3) && IN(5)) xcd_barrier(bar);
#endif
    }
#endif
#if NAIVE_SCAN
    if (IN(4)) { scan_norm_phase(a, vcu, G); SEAM(4); }
#endif
#ifndef NO_P5
    if (IN(5)) {
        pg8::Gemm g{(const bf16*)(ws + WS_Y), (const bf16*)(ws + WS_WOT), MTOK, DMODEL, DMODEL}; pg8::StaticOrder S; S.init(MTOK, DMODEL, G, bx);
        pg8::EpiOut E{a.x, a.out, (float*)(ws + WS_SSQO)};
        for (int rep = 0; rep < DUP(5); ++rep) pg8::gemm_phase<pg8::EpiOut, pg8::StaticOrder, true, PG8_SP2>(lds, g, S, E);
        SEAM(5);
    }
#endif
    if (IN(6)) final_norm_phase(a, vcu, G);
#undef IN
#undef SEAM
}

extern "C" void kernel_launch(void* const* d_in, const int* in_sizes, int n_in, void* d_out, int out_size, void* d_ws, size_t ws_size, hipStream_t stream) {
    static int grid = 0;
    if (grid == 0) {
        if (n_in != 12 || in_sizes[0] != MTOK * DMODEL || out_size != MTOK * DMODEL || ws_size < WS_END) { fprintf(stderr, "kernel_launch: unexpected shapes (n_in %d, in0 %d, out %d, ws %zu); nothing launched\n", n_in, n_in > 0 ? in_sizes[0] : -1, out_size, ws_size); grid = -1; return; }
        int dev = 0, cus = 0, per_cu = 0;
        if (hipGetDevice(&dev) != hipSuccess || hipDeviceGetAttribute(&cus, hipDeviceAttributeMultiprocessorCount, dev) != hipSuccess) { fprintf(stderr, "kernel_launch: device query failed\n"); grid = -1; return; }
        if (hipFuncSetAttribute((const void*)hyb_fwd, hipFuncAttributeMaxDynamicSharedMemorySize, LDS_BYTES) != hipSuccess) { fprintf(stderr, "kernel_launch: hipFuncSetAttribute failed\n"); grid = -1; return; }
        if (hipOccupancyMaxActiveBlocksPerMultiprocessor(&per_cu, (const void*)hyb_fwd, NTHREADS, LDS_BYTES) != hipSuccess || per_cu < 1) { fprintf(stderr, "kernel_launch: occupancy query reports %d workgroups per CU\n", per_cu); per_cu = 1; }
        (void)hipGetLastError();
        grid = cus;
    }
    if (grid < 0) return;
    if (hipMemsetAsync((char*)d_ws + WS_CTL, 0, CTL_ZERO_BYTES, stream) != hipSuccess) { fprintf(stderr, "kernel_launch: hipMemsetAsync failed\n"); return; }
    Args a{};
    a.x = (const float*)d_in[0]; a.pos = (const int*)d_in[1]; a.ln_g = (const float*)d_in[2]; a.w_in = (const float*)d_in[3]; a.qn_g = (const float*)d_in[4]; a.w_q_b = (const float*)d_in[5];
    a.kvn_g = (const float*)d_in[6]; a.w_kv_b = (const float*)d_in[7]; a.hg_lb = (const float*)d_in[8]; a.hg_ng = (const float*)d_in[9]; a.w_out = (const float*)d_in[10]; a.fn_g = (const float*)d_in[11];
    a.out = (float*)d_out; a.ws = (unsigned char*)d_ws;
#if MK_PER_PHASE
    for (int p = 0; p < N_PHASES; ++p) { a.ph_lo = p; a.ph_hi = p + 1; hipLaunchKernelGGL(hyb_fwd, dim3(grid), dim3(NTHREADS), LDS_BYTES, stream, a); }
#else
    a.ph_lo = 0; a.ph_hi = N_PHASES; hipLaunchKernelGGL(hyb_fwd, dim3(grid), dim3(NTHREADS), LDS_BYTES, stream, a);
#endif
    const hipError_t le = hipPeekAtLastError();
    if (le != hipSuccess) fprintf(stderr, "kernel_launch: launch failed: %s\n", hipGetErrorName(le));
}
```
